# Optimizing an MI355X kernel written in HIP

```python
import jax, jax.numpy as jnp
from jax import lax
import numpy as np

D_MODEL = 1024
BATCH = 2
SEQ = 16384
DEPTH = 4

SC_WIDTH = D_MODEL
CONV_K = 3
GMLP_WIDTH = D_MODEL
GMLP_GROUPS = 8
GMLP_GROUP_DIM = GMLP_WIDTH // GMLP_GROUPS
CHUNK = 128
N_EXPERTS = 32
TOP_K = 4
D_FF = D_MODEL
SWIGLU_LIMIT = 7.0
SWIGLU_ALPHA = 1.702
MOE_BLOCK = 256
NORM_EPS = 1e-6
D_IN = 3 * SC_WIDTH + 2 * GMLP_WIDTH + 2 * D_MODEL

kernel_name = "hybrid_conv_gmlp_moe_adaln_trunk"


def rms_norm(x, g):
    xf = x.astype(jnp.float32)
    y = xf * lax.rsqrt(jnp.mean(xf * xf, axis=-1, keepdims=True) + NORM_EPS)
    return (y * g.astype(jnp.float32)).astype(x.dtype)


def layer_norm(x, g):
    xf = x.astype(jnp.float32)
    mu = jnp.mean(xf, axis=-1, keepdims=True)
    xc = xf - mu
    var = jnp.mean(xc * xc, axis=-1, keepdims=True)
    return (xc * lax.rsqrt(var + NORM_EPS) * g.astype(jnp.float32)).astype(x.dtype)


def modulate(h, shift, scale):
    return h * (1 + scale) + shift


def causal_dwconv3(z, w):
    z1 = jnp.pad(z, ((0, 0), (1, 0), (0, 0)))[:, :-1]
    z2 = jnp.pad(z, ((0, 0), (2, 0), (0, 0)))[:, :-2]
    return w[0] * z2 + w[1] * z1 + w[2] * z


def chunked_spatial_gate(u, v, w_s, b_s):
    bsz, seq, _ = v.shape
    vc = v.reshape(bsz, seq // CHUNK, CHUNK, GMLP_GROUPS, GMLP_GROUP_DIM)
    mask = jnp.tril(jnp.ones((CHUNK, CHUNK), dtype=w_s.dtype))
    s = jnp.einsum("gts,bnsgc->bntgc", w_s * mask, vc) + b_s.T[:, :, None]
    return u * s.reshape(bsz, seq, GMLP_WIDTH)


def hybrid_mixer(h, w_in, conv_w, w_s, b_s, ln_v_g, w_out):
    z = h @ w_in
    o1 = SC_WIDTH
    o2 = 2 * SC_WIDTH
    o3 = 3 * SC_WIDTH
    o4 = o3 + GMLP_WIDTH
    o5 = o4 + GMLP_WIDTH
    o6 = o5 + D_MODEL
    sc_x, sc_b, sc_c = z[..., :o1], z[..., o1:o2], z[..., o2:o3]
    u, v = z[..., o3:o4], z[..., o4:o5]
    gate_a, gate_b = z[..., o5:o6], z[..., o6:]
    y_a = sc_b * causal_dwconv3(sc_c * sc_x, conv_w)
    u = jax.nn.gelu(u, approximate=False)
    v = layer_norm(jax.nn.gelu(v, approximate=False), ln_v_g)
    y_b = chunked_spatial_gate(u, v, w_s, b_s)
    m = jax.nn.sigmoid(gate_a) * y_a + jax.nn.sigmoid(gate_b) * y_b
    return m @ w_out


def moe_ffn(h, router_w, router_b, w_gu, b_gu, w_dn, b_dn):
    n_tok, d = h.shape
    logits = (h @ router_w + router_b).astype(jnp.float32)
    top_logit, top_e = lax.top_k(logits, TOP_K)
    top_w = jax.nn.softmax(top_logit, axis=-1)
    n_assign = n_tok * TOP_K
    flat_e = top_e.reshape(-1)
    order = jnp.argsort(flat_e)
    sorted_e = flat_e[order]
    sorted_tok = order // TOP_K
    sorted_w = top_w.reshape(-1)[order].astype(h.dtype)
    counts = jnp.bincount(flat_e, length=N_EXPERTS)
    padded = (counts + MOE_BLOCK - 1) // MOE_BLOCK * MOE_BLOCK
    pad_end = jnp.cumsum(padded)
    pad_start = pad_end - padded
    grp_start = jnp.cumsum(counts) - counts
    dest = pad_start[sorted_e] + (jnp.arange(n_assign) - grp_start[sorted_e])
    n_blocks = -(-n_assign // MOE_BLOCK) + N_EXPERTS
    row_tok = jnp.zeros((n_blocks * MOE_BLOCK,), jnp.int32).at[dest].set(sorted_tok)
    block_e = jnp.minimum(
        jnp.searchsorted(pad_end, jnp.arange(n_blocks) * MOE_BLOCK, side="right"), N_EXPERTS - 1)
    xb = h[row_tok].reshape(n_blocks, MOE_BLOCK, d)

    def expert_block(args):
        xs, e = args
        gu = xs @ w_gu[e] + b_gu[e]
        gate, up = gu[:, :D_FF], gu[:, D_FF:]
        gate = jnp.minimum(gate, SWIGLU_LIMIT)
        up = jnp.clip(up, -SWIGLU_LIMIT, SWIGLU_LIMIT)
        act = gate * jax.nn.sigmoid(SWIGLU_ALPHA * gate) * (up + 1)
        return act @ w_dn[e] + b_dn[e]

    yb = lax.map(expert_block, (xb, block_e)).reshape(-1, d)
    y_sorted = yb[dest] * sorted_w[:, None]
    return jax.ops.segment_sum(y_sorted, sorted_tok, num_segments=n_tok)


def setup_inputs(seed: int = 0) -> dict:
    key = jax.random.key(seed)
    ks = jax.random.split(key, 19)

    def nrm(k, shape, std):
        return jax.random.normal(k, shape, jnp.float32) * std

    return {
        "x": nrm(ks[0], (BATCH, SEQ, D_MODEL), 1.0),
        "c": nrm(ks[1], (BATCH, D_MODEL), 1.0),
        "w_ada": nrm(ks[2], (DEPTH, D_MODEL, 6 * D_MODEL), 0.5 * D_MODEL ** -0.5),
        "b_ada": nrm(ks[3], (DEPTH, 6 * D_MODEL), 0.1),
        "norm_mix_g": 1.0 + nrm(ks[4], (DEPTH, D_MODEL), 0.05),
        "w_in": nrm(ks[5], (DEPTH, D_MODEL, D_IN), D_MODEL ** -0.5),
        "conv_w": nrm(ks[6], (DEPTH, CONV_K, SC_WIDTH), CONV_K ** -0.5),
        "w_spatial": nrm(ks[7], (DEPTH, GMLP_GROUPS, CHUNK, CHUNK), CHUNK ** -0.5),
        "b_spatial": 1.0 + nrm(ks[8], (DEPTH, GMLP_GROUPS, CHUNK), 0.1),
        "ln_v_g": 1.0 + nrm(ks[9], (DEPTH, GMLP_WIDTH), 0.05),
        "w_out": nrm(ks[10], (DEPTH, D_MODEL, D_MODEL), D_MODEL ** -0.5),
        "norm_ffn_g": 1.0 + nrm(ks[11], (DEPTH, D_MODEL), 0.05),
        "router_w": nrm(ks[12], (DEPTH, D_MODEL, N_EXPERTS), D_MODEL ** -0.5),
        "router_b": nrm(ks[13], (DEPTH, N_EXPERTS), 0.01),
        "w_gate_up": nrm(ks[14], (DEPTH, N_EXPERTS, D_MODEL, 2 * D_FF), D_MODEL ** -0.5),
        "b_gate_up": nrm(ks[15], (DEPTH, N_EXPERTS, 2 * D_FF), 0.02),
        "w_down": nrm(ks[16], (DEPTH, N_EXPERTS, D_FF, D_MODEL), D_FF ** -0.5),
        "b_down": nrm(ks[17], (DEPTH, N_EXPERTS, D_MODEL), 0.02),
        "final_norm_g": 1.0 + nrm(ks[18], (D_MODEL,), 0.05),
    }


def reference(x, c, w_ada, b_ada, norm_mix_g, w_in, conv_w, w_spatial, b_spatial, ln_v_g,
              w_out, norm_ffn_g, router_w, router_b, w_gate_up, b_gate_up, w_down, b_down,
              final_norm_g):
    bsz, seq, d = x.shape
    cond = jax.nn.silu(c)
    for l in range(DEPTH):
        mod = (cond @ w_ada[l] + b_ada[l])[:, None, :]
        sh_m, sc_m, g_m, sh_f, sc_f, g_f = jnp.split(mod, 6, axis=-1)
        h = modulate(rms_norm(x, norm_mix_g[l]), sh_m, sc_m)
        x = x + g_m * hybrid_mixer(h, w_in[l], conv_w[l], w_spatial[l], b_spatial[l],
                                   ln_v_g[l], w_out[l])
        h = modulate(rms_norm(x, norm_ffn_g[l]), sh_f, sc_f)
        y = moe_ffn(h.reshape(-1, d), router_w[l], router_b[l], w_gate_up[l], b_gate_up[l],
                    w_down[l], b_down[l])
        x = x + g_f * y.reshape(bsz, seq, d)
    return rms_norm(x, final_norm_g)
```

```cpp
#include <hip/hip_runtime.h>
#include <cstdio>
#include <cstdint>

namespace pg8 {
#define PG8_LAS __attribute__((address_space(3)))
typedef unsigned short bf16_t;
typedef short bf16x8 __attribute__((ext_vector_type(8)));
typedef float f32x4 __attribute__((ext_vector_type(4)));
typedef float f32x2 __attribute__((ext_vector_type(2)));
typedef unsigned u32x4 __attribute__((ext_vector_type(4)));
typedef unsigned u32x2 __attribute__((ext_vector_type(2)));
constexpr int BM = 256, BK = 64, HALF = 128, HTB = HALF * BK * 2  , STAGE_BYTES = 8 * HTB, NXCD = 8, WGM = 8;

__host__ __device__ __forceinline__ int lds_byte(int r, int c) { const int st = (r >> 4) * 2 + (c >> 5), rr = r & 15, cc = c & 31, ob = rr * 64 + cc * 2; return st * 1024 + (ob ^ (((ob >> 9) & 1) << 5)); }
__host__ __device__ __forceinline__ void stage_rc(int b, int& R, int& C) { const int st = b / 1024, sb = b % 1024, swz = sb ^ (((sb >> 9) & 1) << 5); R = (st >> 1) * 16 + swz / 64; C = (st & 1) * 32 + (swz % 64) / 2; }
__host__ __device__ __forceinline__ int perm32(int rho) { const int n = rho >> 4, i = rho & 15; return 8 * (i >> 2) + 4 * n + (i & 3); }

struct Unit { int pm, pn, be; };
struct Gemm { const bf16_t* A; const bf16_t* Bt; int K; int pad; size_t bstride; };

struct StaticOrder {
    int nM, nN, nwg, G, c;
    __host__ __device__ void init(int M, int N, int G_, int c_) { nM = M / BM; nN = N / BM; nwg = nM * nN; G = G_; c = c_; }
    __host__ __device__ bool next(int i, Unit& u) const {
        const long L = (long)i * G + c; if (L >= nwg) return false;
        int wgid = (int)L; { const int q = nwg / NXCD, r = nwg % NXCD, xcd = wgid % NXCD, off = wgid / NXCD; wgid = (xcd < r ? xcd * (q + 1) : r * (q + 1) + (xcd - r) * q) + off; }
        const int nig = WGM * nN, gid = wgid / nig, fm = gid * WGM, gsz = (nM - fm) < WGM ? (nM - fm) : WGM;
        u.pm = fm + ((wgid % nig) % gsz); u.pn = (wgid % nig) / gsz; u.be = 0; return true;
    }
    __device__ __forceinline__ void a_ready(const Unit&) const {}
    __device__ __forceinline__ void done(const Unit&) const {}
};
struct GroupedOrder {
    int nM, nN, nwg, G, c; const int* tile_e;
    __device__ void init(int nM_, int nN_, int G_, int c_, const int* te) { nM = nM_; nN = nN_; nwg = nM * nN; G = G_; c = c_; tile_e = te; }
    __device__ bool next(int i, Unit& u) const {
        const long L = (long)i * G + c; if (L >= nwg) return false;
        int wgid = (int)L; { const int q = nwg / NXCD, r = nwg % NXCD, xcd = wgid % NXCD, off = wgid / NXCD; wgid = (xcd < r ? xcd * (q + 1) : r * (q + 1) + (xcd - r) * q) + off; }
        const int nig = WGM * nN, gid = wgid / nig, fm = gid * WGM, gsz = (nM - fm) < WGM ? (nM - fm) : WGM;
        u.pm = fm + ((wgid % nig) % gsz); u.pn = (wgid % nig) / gsz;
        u.be = __builtin_amdgcn_readfirstlane(__hip_atomic_load(tile_e + u.pm, __ATOMIC_RELAXED, __HIP_MEMORY_SCOPE_AGENT)); return true;
    }
    __device__ __forceinline__ void a_ready(const Unit&) const {}
    __device__ __forceinline__ void done(const Unit&) const {}
};

__device__ __forceinline__ unsigned cvt_pk_bf16(float lo, float hi) { unsigned r; asm volatile("v_cvt_pk_bf16_f32 %0, %1, %2" : "=v"(r) : "v"(lo), "v"(hi)); return r; }

struct EpiBf16 {
    static constexpr bool PERM = true, AFTER_DRAIN = false;
    bf16_t* O; int ldc; int bias_stride; const float* bias;
    __device__ __forceinline__ void operator()(const f32x4 (&acc)[2][2][4][2], const Unit& u, int wr, int wc, int fr, int fq) const {
        const int row0 = u.pm * BM + wr * 64 + fr; const int col0 = u.pn * BM + wc * 32 + 8 * fq;
        f32x4 bv[2][2];
#pragma unroll
        for (int bj = 0; bj < 2; ++bj)
#pragma unroll
            for (int n = 0; n < 2; ++n) bv[bj][n] = bias ? *(const f32x4*)(bias + (size_t)u.be * bias_stride + col0 + bj * HALF + 4 * n) : (f32x4){0.f, 0.f, 0.f, 0.f};
#pragma unroll
        for (int ai = 0; ai < 2; ++ai)
#pragma unroll
            for (int m = 0; m < 4; ++m) { bf16_t* rowp = O + (size_t)(row0 + ai * HALF + m * 16) * ldc + col0;
#pragma unroll
                for (int bj = 0; bj < 2; ++bj) { const f32x4 v0 = acc[ai][bj][m][0] + bv[bj][0], v1 = acc[ai][bj][m][1] + bv[bj][1];
                    u32x4 w; w.x = cvt_pk_bf16(v0[0], v0[1]); w.y = cvt_pk_bf16(v0[2], v0[3]); w.z = cvt_pk_bf16(v1[0], v1[1]); w.w = cvt_pk_bf16(v1[2], v1[3]);
                    *(u32x4*)(rowp + bj * HALF) = w; } }
    }
};
struct EpiResidual {
    static constexpr bool PERM = false, AFTER_DRAIN = false;
    const float* base; float* out; const float* gate; int ldc; int rows_per_batch; int gate_stride; int pad;
    __device__ __forceinline__ void operator()(const f32x4 (&acc)[2][2][4][2], const Unit& u, int wr, int wc, int fr, int fq) const {
        const int row0 = u.pm * BM + wr * 64 + fr, col0 = u.pn * BM + wc * 32 + 4 * fq;
        const float* gp = gate + (size_t)((u.pm * BM) / rows_per_batch) * gate_stride;
        f32x4 gv[2][2];
#pragma unroll
        for (int bj = 0; bj < 2; ++bj)
#pragma unroll
            for (int n = 0; n < 2; ++n) gv[bj][n] = *(const f32x4*)(gp + col0 + bj * HALF + n * 16);
#pragma unroll
        for (int ai = 0; ai < 2; ++ai)
#pragma unroll
            for (int m = 0; m < 4; ++m) { const size_t off = (size_t)(row0 + ai * HALF + m * 16) * ldc + col0;
#pragma unroll
                for (int bj = 0; bj < 2; ++bj)
#pragma unroll
                    for (int n = 0; n < 2; ++n) { const f32x4 bs = *(const f32x4*)(base + off + bj * HALF + n * 16); *(f32x4*)(out + off + bj * HALF + n * 16) = bs + gv[bj][n] * acc[ai][bj][m][n]; }
                asm volatile("" ::: "memory"); }
    }
};

template <class Epi, class Sched, bool ALIGN_EPI = false, bool SP2 = false>
__device__ __forceinline__ void gemm_phase(PG8_LAS unsigned char* lds, const Gemm g, const Sched& S, const Epi& E) {
    const int tid = threadIdx.x, wid = __builtin_amdgcn_readfirstlane(tid >> 6), lane = tid & 63, wr = wid >> 2, wc = wid & 3, fr = lane & 15, fq = lane >> 4;
    const int K = g.K, nt = K / BK;
    unsigned voffA[2], voffB[2];
#pragma unroll
    for (int i = 0; i < 2; ++i) { int R, C; stage_rc(tid * 16 + i * 8192, R, C); const int Rb = Epi::PERM ? ((R & ~31) + perm32(R & 31)) : R;
        voffA[i] = (unsigned)(R * K + C) * 2u; voffB[i] = (unsigned)(Rb * K + C) * 2u; }
    const size_t kstep = (size_t)(BK * 2);
    const size_t hstep = (size_t)HALF * K * 2;
    const size_t tstep = 2 * hstep;
    const unsigned ldsw = (unsigned)wid * 1024u;
    const int aoff = lds_byte(wr * 64 + fr, fq * 8), boff = lds_byte(wc * 32 + fr, fq * 8);
#define PG8_SA(b, h) (((b) * 2 + (h)) * HTB)
#define PG8_SB(b, h) ((4 + (b) * 2 + (h)) * HTB)
#define PG8_STAGE(bufoff, gbase, voff) do { _Pragma("unroll") for (int _i = 0; _i < 2; ++_i) \
        __builtin_amdgcn_global_load_lds((const unsigned*)((const char*)(gbase) + (voff)[_i]), (PG8_LAS unsigned*)(lds + (bufoff) + ldsw + _i * 8192), 16, 0, 0); } while (0)
#define PG8_LDA(dst, b, h) do { _Pragma("unroll") for (int m = 0; m < 4; ++m) _Pragma("unroll") for (int k = 0; k < 2; ++k) dst[m][k] = *(const PG8_LAS bf16x8*)(lds + PG8_SA(b, h) + aoff + m * 2048 + k * 1024); } while (0)
#define PG8_LDB(dst, b, h) do { _Pragma("unroll") for (int n = 0; n < 2; ++n) _Pragma("unroll") for (int k = 0; k < 2; ++k) dst[n][k] = *(const PG8_LAS bf16x8*)(lds + PG8_SB(b, h) + boff + n * 2048 + k * 1024); } while (0)
#define PG8_MMA(ai, bj, At, Bt) do { __builtin_amdgcn_s_setprio(1); _Pragma("unroll") for (int m = 0; m < 4; ++m) _Pragma("unroll") for (int n = 0; n < 2; ++n) _Pragma("unroll") for (int k = 0; k < 2; ++k) \
        acc[ai][bj][m][n] = __builtin_amdgcn_mfma_f32_16x16x32_bf16(Bt[n][k], At[m][k], acc[ai][bj][m][n], 0, 0, 0); __builtin_amdgcn_s_setprio(0); } while (0)
#define PG8_WAIT_V(n) asm volatile("s_waitcnt vmcnt(" #n ")" ::: "memory")
#define PG8_WAIT_L(n) asm volatile("s_waitcnt lgkmcnt(" #n ")" ::: "memory")
#define PG8_BAR __builtin_amdgcn_s_barrier()
#define PG8_SCHED __builtin_amdgcn_sched_barrier(0)
    Unit cur, nxt; int ui = 0;
    if (!S.next(0, cur)) return;
    f32x4 acc[2][2][4][2];
#pragma unroll
    for (int a = 0; a < 2; ++a)
#pragma unroll
        for (int b = 0; b < 2; ++b)
#pragma unroll
            for (int m = 0; m < 4; ++m)
#pragma unroll
                for (int n = 0; n < 2; ++n) acc[a][b][m][n] = (f32x4){0.f, 0.f, 0.f, 0.f};
    bf16x8 At[4][2], B0[2][2], B1[2][2];
    const char* cA = (const char*)g.A + (size_t)cur.pm * tstep; const char* cB = (const char*)g.Bt + (size_t)cur.be * g.bstride + (size_t)cur.pn * tstep;
    S.a_ready(cur);
    if constexpr (SP2) {
        PG8_STAGE(PG8_SB(0, 0), cB, voffB); PG8_STAGE(PG8_SB(0, 1), cB + hstep, voffB); PG8_STAGE(PG8_SA(0, 0), cA, voffA); PG8_STAGE(PG8_SA(0, 1), cA + hstep, voffA);
        if (wr == 1) PG8_BAR;
        PG8_WAIT_V(2); PG8_BAR;
        PG8_STAGE(PG8_SB(1, 0), cB + kstep, voffB); PG8_STAGE(PG8_SA(1, 0), cA + kstep, voffA); PG8_STAGE(PG8_SB(1, 1), cB + hstep + kstep, voffB);
        PG8_WAIT_V(6); PG8_BAR;
    } else {
        PG8_STAGE(PG8_SB(0, 0), cB, voffB); PG8_STAGE(PG8_SA(0, 0), cA, voffA); PG8_STAGE(PG8_SB(0, 1), cB + hstep, voffB); PG8_STAGE(PG8_SA(0, 1), cA + hstep, voffA);
        if (wr == 1) PG8_BAR;
        PG8_WAIT_V(4); PG8_BAR;
        PG8_STAGE(PG8_SB(1, 0), cB + kstep, voffB); PG8_STAGE(PG8_SA(1, 0), cA + kstep, voffA); PG8_STAGE(PG8_SB(1, 1), cB + hstep + kstep, voffB);
        PG8_WAIT_V(6); PG8_BAR;
    }
    for (;;) {
        const bool has_next = S.next(ui + 1, nxt);
        const char* nA = has_next ? (const char*)g.A + (size_t)nxt.pm * tstep : cA; const char* nB = has_next ? (const char*)g.Bt + (size_t)nxt.be * g.bstride + (size_t)nxt.pn * tstep : cB;
        for (int t = 0; t < nt; t += 2) {
            const bool last = (t == nt - 2);
            const char* a1 = cA + (size_t)(t + 1) * kstep;
            const char* a2 = last ? nA : cA + (size_t)(t + 2) * kstep; const char* b2 = last ? nB : cB + (size_t)(t + 2) * kstep;
            const char* a3 = a2 + kstep; const char* b3 = b2 + kstep;
            if (last && has_next) S.a_ready(nxt);
            if constexpr (SP2) {
            PG8_LDB(B0, 0, 0); PG8_LDB(B1, 0, 1); PG8_SCHED; PG8_LDA(At, 0, 0); PG8_STAGE(PG8_SA(1, 1), a1 + hstep, voffA);
            PG8_WAIT_V(8); PG8_WAIT_L(0); PG8_BAR; PG8_MMA(0, 0, At, B0); PG8_MMA(0, 1, At, B1); PG8_BAR; PG8_SCHED;
            PG8_LDA(At, 0, 1); PG8_STAGE(PG8_SB(0, 0), b2, voffB); PG8_STAGE(PG8_SB(0, 1), b2 + hstep, voffB); PG8_STAGE(PG8_SA(0, 0), a2, voffA);
            PG8_WAIT_V(8); PG8_WAIT_L(0); PG8_BAR; PG8_MMA(1, 0, At, B0); PG8_MMA(1, 1, At, B1); PG8_BAR; PG8_SCHED;
            PG8_LDB(B0, 1, 0); PG8_LDB(B1, 1, 1); PG8_SCHED; PG8_LDA(At, 1, 0); PG8_STAGE(PG8_SA(0, 1), a2 + hstep, voffA);
            PG8_WAIT_V(8); PG8_WAIT_L(0); PG8_BAR; PG8_MMA(0, 0, At, B0); PG8_MMA(0, 1, At, B1); PG8_BAR; PG8_SCHED;
            PG8_LDA(At, 1, 1); PG8_STAGE(PG8_SB(1, 0), b3, voffB); PG8_STAGE(PG8_SB(1, 1), b3 + hstep, voffB); PG8_STAGE(PG8_SA(1, 0), a3, voffA);
            PG8_WAIT_V(8); PG8_WAIT_L(0); PG8_BAR; PG8_MMA(1, 0, At, B0); PG8_MMA(1, 1, At, B1); PG8_BAR; PG8_SCHED;
            } else {
            PG8_LDB(B0, 0, 0); PG8_SCHED; PG8_LDA(At, 0, 0); PG8_STAGE(PG8_SA(1, 1), a1 + hstep, voffA);
            PG8_WAIT_L(8); PG8_BAR; PG8_WAIT_L(0); PG8_MMA(0, 0, At, B0); PG8_BAR; PG8_SCHED;
            PG8_LDB(B1, 0, 1); PG8_STAGE(PG8_SB(0, 0), b2, voffB);
            PG8_BAR; PG8_WAIT_L(0); PG8_MMA(0, 1, At, B1); PG8_BAR;
            PG8_LDA(At, 0, 1); PG8_STAGE(PG8_SA(0, 0), a2, voffA);
            PG8_BAR; PG8_WAIT_L(0); PG8_MMA(1, 0, At, B0); PG8_BAR; PG8_SCHED;
            PG8_STAGE(PG8_SB(0, 1), b2 + hstep, voffB);
            PG8_WAIT_V(6); PG8_BAR; PG8_MMA(1, 1, At, B1); PG8_BAR;
            PG8_LDB(B0, 1, 0); PG8_SCHED; PG8_LDA(At, 1, 0); PG8_STAGE(PG8_SA(0, 1), a2 + hstep, voffA);
            PG8_WAIT_L(8); PG8_BAR; PG8_WAIT_L(0); PG8_MMA(0, 0, At, B0); PG8_BAR; PG8_SCHED;
            PG8_LDB(B1, 1, 1); PG8_STAGE(PG8_SB(1, 0), b3, voffB);
            PG8_BAR; PG8_WAIT_L(0); PG8_MMA(0, 1, At, B1); PG8_BAR;
            PG8_LDA(At, 1, 1); PG8_STAGE(PG8_SA(1, 0), a3, voffA);
            PG8_BAR; PG8_WAIT_L(0); PG8_MMA(1, 0, At, B0); PG8_BAR; PG8_SCHED;
            PG8_STAGE(PG8_SB(1, 1), b3 + hstep, voffB);
            PG8_WAIT_V(6); PG8_BAR; PG8_MMA(1, 1, At, B1); PG8_BAR;
            }
        }
        if constexpr (ALIGN_EPI) { if (wr == 0) PG8_BAR; }
        if constexpr (!Epi::AFTER_DRAIN) { E(acc, cur, wr, wc, fr, fq); S.done(cur); }
        if (!has_next) break;
#pragma unroll
        for (int a = 0; a < 2; ++a)
#pragma unroll
            for (int b = 0; b < 2; ++b)
#pragma unroll
                for (int m = 0; m < 4; ++m)
#pragma unroll
                    for (int n = 0; n < 2; ++n) acc[a][b][m][n] = (f32x4){0.f, 0.f, 0.f, 0.f};
        cur = nxt; cA = nA; cB = nB; ++ui;
        if constexpr (ALIGN_EPI) { if (wr == 1) PG8_BAR; }
    }
    PG8_WAIT_V(0);
    if constexpr (!ALIGN_EPI) { if (wr == 0) PG8_BAR; }
    PG8_BAR;
    if constexpr (Epi::AFTER_DRAIN) { E.fused(acc, cur, wr, wc, fr, fq, lds, wid, lane); S.done(cur); }
#undef PG8_SA
#undef PG8_SB
#undef PG8_STAGE
#undef PG8_LDA
#undef PG8_LDB
#undef PG8_MMA
#undef PG8_WAIT_V
#undef PG8_WAIT_L
#undef PG8_BAR
#undef PG8_SCHED
}
}

#define LAS __attribute__((address_space(3)))
typedef unsigned short bf16;
typedef float f32x4 __attribute__((ext_vector_type(4)));
typedef unsigned u32x4 __attribute__((ext_vector_type(4)));
typedef unsigned u32x2 __attribute__((ext_vector_type(2)));
constexpr int NB = 2, SEQ = 16384, T = NB * SEQ, D = 1024, DIN = 7168, NE = 32, TOPK = 4, DFF = 1024, NL = 4, CHK = 128, NG = 8;
constexpr int NCHUNK = T / CHK;
constexpr int NASSIGN = T * TOPK;
constexpr int NTILE_MAX = NASSIGN / 256 + NE;
constexpr int NROW_MAX = NTILE_MAX * 256;
constexpr float EPS = 1e-6f;
constexpr int NWAVES = 8, NTHREADS = 512;
constexpr int LDS_BYTES = 147456;

constexpr size_t al4k(size_t x) { return (x + 4095) & ~(size_t)4095; }
constexpr size_t WS_CTL = 0, CTL_BYTES = 1u << 20;
constexpr size_t WS_MOD = WS_CTL + CTL_BYTES;
constexpr size_t WS_RT = WS_MOD + al4k((size_t)NL * 2 * 6144 * 4);
constexpr size_t WS_CNT = WS_RT + al4k((size_t)NL * NE * D * 4);
constexpr size_t WS_TAB = WS_CNT + al4k((size_t)NCHUNK * NE * 4);
constexpr size_t WS_AE = WS_TAB + al4k(4096);
constexpr size_t WS_AR = WS_AE + al4k((size_t)NASSIGN * 4);
constexpr size_t WS_AW = WS_AR + al4k((size_t)NASSIGN * 4);
constexpr size_t WS_AROW = WS_AW + al4k((size_t)NASSIGN * 4);
constexpr size_t WS_ROWTOK = WS_AROW + al4k((size_t)NASSIGN * 4);
constexpr size_t WS_WIN = WS_ROWTOK + al4k((size_t)NROW_MAX * 4);
constexpr size_t WS_WOUT = WS_WIN + al4k((size_t)NL * DIN * D * 2);
constexpr size_t WS_WGU = WS_WOUT + al4k((size_t)NL * D * D * 2);
constexpr size_t WS_WDN = WS_WGU + al4k((size_t)NL * NE * 2 * DFF * D * 2);
constexpr size_t WS_XRES = WS_WDN + al4k((size_t)NL * NE * D * DFF * 2);
constexpr size_t WS_H = WS_XRES + al4k((size_t)T * D * 4);
constexpr size_t WS_Z = WS_H + al4k((size_t)T * D * 2);
constexpr size_t WS_M = WS_Z + al4k((size_t)T * DIN * 2);
constexpr size_t WS_XB = WS_M + al4k((size_t)T * D * 2);
constexpr size_t WS_GU = WS_XB + al4k((size_t)NROW_MAX * D * 2);
constexpr size_t WS_ACT = WS_GU + al4k((size_t)NROW_MAX * 2 * DFF * 2);
constexpr size_t WS_Y = WS_ACT + al4k((size_t)NROW_MAX * DFF * 2);
constexpr size_t WS_END = WS_Y + al4k((size_t)NROW_MAX * D * 2);

struct P { const float* in[19]; float* out; unsigned char* ws; };

__device__ __forceinline__ unsigned f2bf(float f) { unsigned u = __builtin_bit_cast(unsigned, f); return (u + 0x7fffu + ((u >> 16) & 1u)) >> 16; }
__device__ __forceinline__ unsigned pk2(float lo, float hi) { return f2bf(lo) | (f2bf(hi) << 16); }
__device__ __forceinline__ float bf2f(unsigned short b) { return __builtin_bit_cast(float, (unsigned)b << 16); }
__device__ __forceinline__ float bflo(unsigned w) { return __builtin_bit_cast(float, w << 16); }
__device__ __forceinline__ float bfhi(unsigned w) { return __builtin_bit_cast(float, w & 0xffff0000u); }
__device__ __forceinline__ float wave_sum(float v) {
#pragma unroll
    for (int o = 1; o < 64; o <<= 1) v += __shfl_xor(v, o);
    return v;
}
__device__ __forceinline__ float gelu_erf(float x) { return 0.5f * x * (1.0f + erff(x * 0.70710678118654752f)); }
__device__ __forceinline__ float sigmoidf_(float x) { return 1.0f / (1.0f + __expf(-x)); }

struct Ctx { int tid, lane, wave, gw, ngw; LAS unsigned char* lds; };

__device__ __forceinline__ void transpose_item(const float* W, int K, int N, bf16* WT, LAS float* scr, int item, int lane) {
    const int nblk = N / 32, kb = item / nblk, nb = item % nblk, k0 = 64 * kb, n0 = 32 * nb;
#pragma unroll 8
    for (int i = 0; i < 32; ++i) { const int kk = 2 * i + (lane >> 5); scr[kk * 33 + (lane & 31)] = W[(size_t)(k0 + kk) * N + n0 + (lane & 31)]; }
    asm volatile("s_waitcnt lgkmcnt(0)" ::: "memory");
    const int c = lane & 7;
#pragma unroll
    for (int j = 0; j < 4; ++j) { const int n = (lane >> 3) + 8 * j; const LAS float* s = scr + (8 * c) * 33 + n;
        u32x4 o; o.x = pk2(s[0 * 33], s[1 * 33]); o.y = pk2(s[2 * 33], s[3 * 33]); o.z = pk2(s[4 * 33], s[5 * 33]); o.w = pk2(s[6 * 33], s[7 * 33]);
        *(u32x4*)(WT + (size_t)(n0 + n) * K + k0 + 8 * c) = o; }
    asm volatile("s_waitcnt lgkmcnt(0)" ::: "memory");
}

__device__ __forceinline__ void phase_prologue(const P& p, const Ctx& cx) {
    {
        const float* c = p.in[1]; const float* w_ada = p.in[2]; const float* b_ada = p.in[3];
        float* mod = (float*)(p.ws + WS_MOD);
        LAS float* red = (LAS float*)cx.lds;
        const int h = cx.lane >> 5, li = cx.lane & 31;
        for (int item = blockIdx.x; item < NL * 48; item += gridDim.x) {
            const int l = item / 48, col0 = (item % 48) * 128;
            f32x4 a0 = (f32x4){0.f, 0.f, 0.f, 0.f}, a1 = a0;
            const float* wp = w_ada + ((size_t)l * D + cx.wave * 128) * 6144 + col0 + 4 * li;
            for (int i = 0; i < 64; ++i) {
                const int kk = 2 * i + h, k = cx.wave * 128 + kk;
                const float c0 = c[k], c1 = c[D + k];
                const float s0 = c0 / (1.0f + expf(-c0)), s1 = c1 / (1.0f + expf(-c1));
                const f32x4 wv = *(const f32x4*)(wp + (size_t)kk * 6144);
                a0 += wv * s0; a1 += wv * s1;
            }
#pragma unroll
            for (int j = 0; j < 4; ++j) { a0[j] += __shfl_xor(a0[j], 32); a1[j] += __shfl_xor(a1[j], 32); }
            if (h == 0) { *(LAS f32x4*)(red + (cx.wave * 2 + 0) * 128 + 4 * li) = a0; *(LAS f32x4*)(red + (cx.wave * 2 + 1) * 128 + 4 * li) = a1; }
            __syncthreads();
            if (cx.tid < 256) { const int b = cx.tid >> 7, col = cx.tid & 127; float s = b_ada[l * 6144 + col0 + col];
#pragma unroll
                for (int w = 0; w < 8; ++w) s += red[(w * 2 + b) * 128 + col];
                mod[(size_t)(l * 2 + b) * 6144 + col0 + col] = s; }
            __syncthreads();
        }
    }
    {
        const float* rw = p.in[12]; float* RT = (float*)(p.ws + WS_RT);
        for (int idx = blockIdx.x * NTHREADS + cx.tid; idx < NL * NE * D; idx += gridDim.x * NTHREADS) {
            const int l = idx / (NE * D), r = idx % (NE * D), e = r / D, k = r % D;
            RT[idx] = rw[((size_t)l * D + k) * NE + e];
        }
    }
    {
        LAS float* scr = (LAS float*)(cx.lds + cx.wave * 16384);
        constexpr int I_GU = 16 * 64, I_DN = 16 * 32, I_IN = 16 * 224, I_OUT = 16 * 32;
        constexpr int N_GU = NL * NE * I_GU, N_DN = NL * NE * I_DN, N_IN = NL * I_IN, N_OUT = NL * I_OUT;
        constexpr int NITEMS = N_GU + N_DN + N_IN + N_OUT;
        for (int it = cx.gw; it < NITEMS; it += cx.ngw) {
            int r = it;
            if (r < N_GU) { const int mi = r / I_GU; transpose_item(p.in[14] + (size_t)mi * D * 2 * DFF, D, 2 * DFF, (bf16*)(p.ws + WS_WGU) + (size_t)mi * 2 * DFF * D, scr, r % I_GU, cx.lane); continue; } r -= N_GU;
            if (r < N_DN) { const int mi = r / I_DN; transpose_item(p.in[16] + (size_t)mi * DFF * D, DFF, D, (bf16*)(p.ws + WS_WDN) + (size_t)mi * D * DFF, scr, r % I_DN, cx.lane); continue; } r -= N_DN;
            if (r < N_IN) { const int mi = r / I_IN; transpose_item(p.in[5] + (size_t)mi * D * DIN, D, DIN, (bf16*)(p.ws + WS_WIN) + (size_t)mi * DIN * D, scr, r % I_IN, cx.lane); continue; } r -= N_IN;
            { const int mi = r / I_OUT; transpose_item(p.in[10] + (size_t)mi * D * D, D, D, (bf16*)(p.ws + WS_WOUT) + (size_t)mi * D * D, scr, r % I_OUT, cx.lane); }
        }
    }
}

template <int MODE>
__device__ __forceinline__ void phase_norm1(const P& p, const Ctx& cx, int l) {
    const float* mod = (const float*)(p.ws + WS_MOD);
    float* xres = (float*)(p.ws + WS_XRES);
    bf16* H = (bf16*)(p.ws + WS_H);
    const bf16* Y = (const bf16*)(p.ws + WS_Y);
    const int* arow = (const int*)(p.ws + WS_AROW); const float* aw = (const float*)(p.ws + WS_AW);
    for (int row = cx.gw; row < T; row += cx.ngw) {
        const int b = row / SEQ;
        f32x4 v[4];
        if (MODE == 0) { const f32x4* xr = (const f32x4*)(p.in[0] + (size_t)row * D) + cx.lane;
#pragma unroll
            for (int j = 0; j < 4; ++j) v[j] = xr[64 * j];
        } else {
            const f32x4* xr = (const f32x4*)(xres + (size_t)row * D) + cx.lane;
            const f32x4* gf = (const f32x4*)(mod + (size_t)((l - 1) * 2 + b) * 6144 + 5 * D) + cx.lane;
            f32x4 acc[4];
#pragma unroll
            for (int j = 0; j < 4; ++j) { v[j] = xr[64 * j]; acc[j] = (f32x4){0.f, 0.f, 0.f, 0.f}; }
#pragma unroll
            for (int k = 0; k < TOPK; ++k) {
                const int r = arow[row * 4 + k]; const float w = aw[row * 4 + k];
                const u32x2* yr = (const u32x2*)(Y + (size_t)r * D) + cx.lane;
#pragma unroll
                for (int j = 0; j < 4; ++j) { const u32x2 q = yr[64 * j]; acc[j] += (f32x4){bflo(q.x), bfhi(q.x), bflo(q.y), bfhi(q.y)} * w; }
            }
            f32x4* xw = (f32x4*)(xres + (size_t)row * D) + cx.lane;
#pragma unroll
            for (int j = 0; j < 4; ++j) { v[j] += gf[64 * j] * acc[j]; if (MODE == 1) xw[64 * j] = v[j]; }
        }
        float ss = 0.f;
#pragma unroll
        for (int j = 0; j < 4; ++j) ss += (v[j].x * v[j].x + v[j].y * v[j].y) + (v[j].z * v[j].z + v[j].w * v[j].w);
        const float rstd = 1.0f / sqrtf(wave_sum(ss) * (1.0f / D) + EPS);
        if (MODE == 2) {
            const f32x4* g = (const f32x4*)(p.in[18]) + cx.lane; f32x4* o = (f32x4*)(p.out + (size_t)row * D) + cx.lane;
#pragma unroll
            for (int j = 0; j < 4; ++j) o[64 * j] = v[j] * rstd * g[64 * j];
        } else {
            const f32x4* g = (const f32x4*)(p.in[4] + (size_t)l * D) + cx.lane;
            const f32x4* sh = (const f32x4*)(mod + (size_t)(l * 2 + b) * 6144 + 0 * D) + cx.lane;
            const f32x4* sc = (const f32x4*)(mod + (size_t)(l * 2 + b) * 6144 + 1 * D) + cx.lane;
            u32x2* o = (u32x2*)(H + (size_t)row * D) + cx.lane;
#pragma unroll
            for (int j = 0; j < 4; ++j) { const f32x4 hh = v[j] * rstd * g[64 * j] * (sc[64 * j] + 1.0f) + sh[64 * j]; u32x2 w; w.x = pk2(hh.x, hh.y); w.y = pk2(hh.z, hh.w); o[64 * j] = w; }
        }
    }
}

__device__ __forceinline__ void phase_mixer(const P& p, const Ctx& cx, int l) {
    const bf16* Z = (const bf16*)(p.ws + WS_Z); bf16* MB = (bf16*)(p.ws + WS_M);
    const float* conv_w = p.in[6] + (size_t)l * 3 * D; const float* w_s = p.in[7] + (size_t)l * NG * CHK * CHK; const float* b_s = p.in[8] + (size_t)l * NG * CHK; const float* ln_g = p.in[9] + (size_t)l * D;
    LAS float* Wt = (LAS float*)cx.lds;
    LAS float* vn = (LAS float*)(cx.lds + 67584);
    LAS float* st = (LAS float*)(cx.lds + 67584 + 65536);
    for (int chunk = blockIdx.x; chunk < NCHUNK; chunk += gridDim.x) {
        const int tok0 = chunk * CHK;
        for (int i = 0; i < 16; ++i) {
            const int t = cx.wave * 16 + i;
            const u32x2* vr = (const u32x2*)(Z + (size_t)(tok0 + t) * DIN + 4 * D) + cx.lane;
            float g[16]; float s = 0.f;
#pragma unroll
            for (int j = 0; j < 4; ++j) { const u32x2 w = vr[64 * j]; g[4 * j + 0] = gelu_erf(bflo(w.x)); g[4 * j + 1] = gelu_erf(bfhi(w.x)); g[4 * j + 2] = gelu_erf(bflo(w.y)); g[4 * j + 3] = gelu_erf(bfhi(w.y));
                s += (g[4 * j + 0] + g[4 * j + 1]) + (g[4 * j + 2] + g[4 * j + 3]); }
            const float mean = wave_sum(s) * (1.0f / D); float q = 0.f;
#pragma unroll
            for (int j = 0; j < 16; ++j) { const float d = g[j] - mean; q += d * d; }
            const float rstd = 1.0f / sqrtf(wave_sum(q) * (1.0f / D) + EPS);
            if (cx.lane == 0) { st[t] = mean; st[128 + t] = rstd; }
        }
        __syncthreads();
        for (int g = 0; g < NG; ++g) {
            for (int idx = cx.tid; idx < CHK * CHK; idx += NTHREADS) { const int t = idx >> 7, s = idx & 127; Wt[s * 132 + t] = (s <= t) ? w_s[((size_t)g * CHK + t) * CHK + s] : 0.f; }
            for (int idx = cx.tid; idx < CHK * 32; idx += NTHREADS) { const int s = idx >> 5, c4 = (idx & 31) * 4;
                const u32x2 w = *(const u32x2*)(Z + (size_t)(tok0 + s) * DIN + 4 * D + g * CHK + c4); const float mu = st[s], rs = st[128 + s]; const f32x4 lg = *(const f32x4*)(ln_g + g * CHK + c4);
                vn[s * 128 + c4 + 0] = (gelu_erf(bflo(w.x)) - mu) * rs * lg[0]; vn[s * 128 + c4 + 1] = (gelu_erf(bfhi(w.x)) - mu) * rs * lg[1];
                vn[s * 128 + c4 + 2] = (gelu_erf(bflo(w.y)) - mu) * rs * lg[2]; vn[s * 128 + c4 + 3] = (gelu_erf(bfhi(w.y)) - mu) * rs * lg[3]; }
            __syncthreads();
            const int c = cx.tid & 127, tq = cx.tid >> 7, ch = g * CHK + c;
            const float cw0 = conv_w[ch], cw1 = conv_w[D + ch], cw2 = conv_w[2 * D + ch];
            for (int i = 0; i < 8; ++i) {
                const int t0 = 4 * (tq + 4 * i); float a[4] = {0.f, 0.f, 0.f, 0.f};
                for (int s = 0; s <= t0 + 3; ++s) { const float vv = vn[s * 128 + c]; const f32x4 w4 = *(const LAS f32x4*)(Wt + s * 132 + t0); a[0] += w4[0] * vv; a[1] += w4[1] * vv; a[2] += w4[2] * vv; a[3] += w4[3] * vv; }
#pragma unroll
                for (int ii = 0; ii < 4; ++ii) {
                    const int t = t0 + ii, tok = tok0 + t, tseq = tok & (SEQ - 1);
                    const bf16* zr = Z + (size_t)tok * DIN + ch;
                    const float sout = a[ii] + b_s[g * CHK + t];
                    const float yB = gelu_erf(bf2f(zr[3 * D])) * sout;
                    const float p0 = bf2f(zr[2 * D]) * bf2f(zr[0]);
                    const float p1 = (tseq >= 1) ? bf2f(zr[2 * D - DIN]) * bf2f(zr[-DIN]) : 0.f;
                    const float p2 = (tseq >= 2) ? bf2f(zr[2 * D - 2 * DIN]) * bf2f(zr[-2 * DIN]) : 0.f;
                    const float yA = bf2f(zr[D]) * (cw0 * p2 + cw1 * p1 + cw2 * p0);
                    const float mm = sigmoidf_(bf2f(zr[5 * D])) * yA + sigmoidf_(bf2f(zr[6 * D])) * yB;
                    MB[(size_t)tok * D + ch] = (bf16)f2bf(mm);
                }
            }
            __syncthreads();
        }
    }
}

__device__ __forceinline__ void phase_router(const P& p, const Ctx& cx, int l) {
    const float* mod = (const float*)(p.ws + WS_MOD); const float* xres = (const float*)(p.ws + WS_XRES); bf16* H = (bf16*)(p.ws + WS_H);
    const float* RT = (const float*)(p.ws + WS_RT) + (size_t)l * NE * D; const float* rb = p.in[13] + l * NE;
    int* cnt = (int*)(p.ws + WS_CNT); int* ae = (int*)(p.ws + WS_AE); int* ar = (int*)(p.ws + WS_AR); float* aw = (float*)(p.ws + WS_AW);
    LAS int* wcnt = (LAS int*)cx.lds;
    LAS int* wbase = (LAS int*)(cx.lds + 1024);
    LAS int* la = (LAS int*)(cx.lds + 2048);
    for (int chunk = blockIdx.x; chunk < NCHUNK; chunk += gridDim.x) {
        int counter = 0;
        for (int i = 0; i < 16; ++i) {
            const int row = chunk * CHK + cx.wave * 16 + i, b = row / SEQ;
            const f32x4* xr = (const f32x4*)(xres + (size_t)row * D) + cx.lane;
            f32x4 v[4]; float ss = 0.f;
#pragma unroll
            for (int j = 0; j < 4; ++j) { v[j] = xr[64 * j]; ss += (v[j].x * v[j].x + v[j].y * v[j].y) + (v[j].z * v[j].z + v[j].w * v[j].w); }
            const float rstd = 1.0f / sqrtf(wave_sum(ss) * (1.0f / D) + EPS);
            const f32x4* g = (const f32x4*)(p.in[11] + (size_t)l * D) + cx.lane;
            const f32x4* sh = (const f32x4*)(mod + (size_t)(l * 2 + b) * 6144 + 3 * D) + cx.lane;
            const f32x4* sc = (const f32x4*)(mod + (size_t)(l * 2 + b) * 6144 + 4 * D) + cx.lane;
            u32x2* o = (u32x2*)(H + (size_t)row * D) + cx.lane;
#pragma unroll
            for (int j = 0; j < 4; ++j) { v[j] = v[j] * rstd * g[64 * j] * (sc[64 * j] + 1.0f) + sh[64 * j]; u32x2 w; w.x = pk2(v[j].x, v[j].y); w.y = pk2(v[j].z, v[j].w); o[64 * j] = w; }
            float mylg = -3.0e38f;
#pragma unroll 2
            for (int e = 0; e < NE; ++e) { const f32x4* rr = (const f32x4*)(RT + (size_t)e * D) + cx.lane; float s = 0.f;
#pragma unroll
                for (int j = 0; j < 4; ++j) { const f32x4 w = rr[64 * j]; s += (v[j].x * w.x + v[j].y * w.y) + (v[j].z * w.z + v[j].w * w.w); }
                const float tot = wave_sum(s) + rb[e]; mylg = (cx.lane == e) ? tot : mylg; }
            int sel[TOPK]; float sv[TOPK];
#pragma unroll
            for (int k = 0; k < TOPK; ++k) { float val = mylg; int idx = cx.lane;
#pragma unroll
                for (int o = 1; o < 64; o <<= 1) { const float ov = __shfl_xor(val, o); const int oi = __shfl_xor(idx, o); const bool tk = (ov > val) || (ov == val && oi < idx); val = tk ? ov : val; idx = tk ? oi : idx; }
                sel[k] = idx; sv[k] = val; mylg = (cx.lane == idx) ? -3.0e38f : mylg; }
            float ex[TOPK], den = 0.f;
#pragma unroll
            for (int k = 0; k < TOPK; ++k) { ex[k] = expf(sv[k] - sv[0]); den += ex[k]; }
            const float inv = 1.0f / den;
#pragma unroll
            for (int k = 0; k < TOPK; ++k) {
                const int e = sel[k]; const int rank = __shfl(counter, e); counter += (cx.lane == e) ? 1 : 0;
                if (cx.lane == k) { la[cx.wave * 64 + i * 4 + k] = e | (rank << 8); aw[row * 4 + k] = ex[k] * inv; }
            }
        }
        if (cx.lane < NE) wcnt[cx.wave * NE + cx.lane] = counter;
        __syncthreads();
        if (cx.tid < NE) { int tot = 0;
#pragma unroll
            for (int w = 0; w < NWAVES; ++w) { wbase[w * NE + cx.tid] = tot; tot += wcnt[w * NE + cx.tid]; }
            cnt[chunk * NE + cx.tid] = tot; }
        __syncthreads();
        { const int pk = la[cx.wave * 64 + cx.lane], e = pk & 255, r = (pk >> 8) + wbase[cx.wave * NE + e];
          const int a = (chunk * CHK + cx.wave * 16) * 4 + cx.lane; ae[a] = e; ar[a] = r; }
        __syncthreads();
    }
}

__device__ __forceinline__ void phase_scatter(const P& p, const Ctx& cx) {
    const int* cnt = (const int*)(p.ws + WS_CNT); const int* ae = (const int*)(p.ws + WS_AE); const int* ar = (const int*)(p.ws + WS_AR);
    int* arow = (int*)(p.ws + WS_AROW); int* rowtok = (int*)(p.ws + WS_ROWTOK); int* tab = (int*)(p.ws + WS_TAB);
    LAS int* s_tot = (LAS int*)cx.lds; LAS int* s_before = s_tot + 32; LAS int* s_pstart = s_tot + 64; LAS int* s_base = s_tot + 96;
    for (int chunk = blockIdx.x; chunk < NCHUNK; chunk += gridDim.x) {
        if (cx.tid < NE) { int before = 0, total = 0;
            for (int c2 = 0; c2 < NCHUNK; ++c2) { const int v = cnt[c2 * NE + cx.tid]; total += v; before += (c2 < chunk) ? v : 0; }
            s_tot[cx.tid] = total; s_before[cx.tid] = before; }
        __syncthreads();
        if (cx.tid < NE) { int ps = 0; for (int e2 = 0; e2 < cx.tid; ++e2) ps += (s_tot[e2] + 255) & ~255; s_pstart[cx.tid] = ps; s_base[cx.tid] = ps + s_before[cx.tid]; }
        __syncthreads();
        { const int a = chunk * (CHK * TOPK) + cx.tid; const int e = ae[a], r = ar[a]; const int dest = s_base[e] + r; rowtok[dest] = a >> 2; arow[a] = dest; }
        if (chunk < NE) { const int e = chunk, lo = s_pstart[e] + s_tot[e], hi = s_pstart[e] + ((s_tot[e] + 255) & ~255); for (int i = lo + cx.tid; i < hi; i += NTHREADS) rowtok[i] = 0; }
        if (chunk == 0) {
            const int ntiles = (s_pstart[NE - 1] + ((s_tot[NE - 1] + 255) & ~255)) >> 8;
            for (int i = cx.tid; i < NTILE_MAX; i += NTHREADS) { int ee = 0; for (int e = 0; e < NE; ++e) if (s_tot[e] > 0 && s_pstart[e] <= i * 256) ee = e; tab[64 + i] = ee; }
            if (cx.tid == 0) tab[0] = ntiles;
        }
        __syncthreads();
    }
}

__device__ __forceinline__ void phase_gather(const P& p, const Ctx& cx) {
    const int* tab = (const int*)(p.ws + WS_TAB); const int* rowtok = (const int*)(p.ws + WS_ROWTOK);
    const bf16* H = (const bf16*)(p.ws + WS_H); bf16* XB = (bf16*)(p.ws + WS_XB);
    const int nrows = tab[0] * 256;
    for (int r = cx.gw; r < nrows; r += cx.ngw) { const int t = rowtok[r];
        const u32x4* s = (const u32x4*)(H + (size_t)t * D) + cx.lane; u32x4* d = (u32x4*)(XB + (size_t)r * D) + cx.lane; d[0] = s[0]; d[64] = s[64]; }
}
__device__ __forceinline__ void phase_act(const P& p, const Ctx& cx) {
    const int* tab = (const int*)(p.ws + WS_TAB); const bf16* GU = (const bf16*)(p.ws + WS_GU); bf16* ACT = (bf16*)(p.ws + WS_ACT);
    const int nrows = tab[0] * 256;
    for (int r = cx.gw; r < nrows; r += cx.ngw) {
        const u32x4* gr = (const u32x4*)(GU + (size_t)r * 2 * DFF) + cx.lane; u32x4* d = (u32x4*)(ACT + (size_t)r * DFF) + cx.lane;
#pragma unroll
        for (int j = 0; j < 2; ++j) { const u32x4 gq = gr[64 * j], uq = gr[128 + 64 * j]; u32x4 o;
#pragma unroll
            for (int q = 0; q < 4; ++q) { float g0 = bflo(gq[q]), g1 = bfhi(gq[q]), u0 = bflo(uq[q]), u1 = bfhi(uq[q]);
                g0 = fminf(g0, 7.0f); g1 = fminf(g1, 7.0f); u0 = fminf(fmaxf(u0, -7.0f), 7.0f); u1 = fminf(fmaxf(u1, -7.0f), 7.0f);
                o[q] = pk2(g0 * sigmoidf_(1.702f * g0) * (u0 + 1.0f), g1 * sigmoidf_(1.702f * g1) * (u1 + 1.0f)); }
            d[64 * j] = o; }
    }
}

__device__ __forceinline__ void phase_inproj(const P& p, const Ctx& cx, int l) {
    pg8::Gemm g{(const bf16*)(p.ws + WS_H), (const bf16*)(p.ws + WS_WIN) + (size_t)l * DIN * D, D, 0, 0};
    pg8::StaticOrder S; S.init(T, DIN, gridDim.x, blockIdx.x);
    pg8::EpiBf16 E{(bf16*)(p.ws + WS_Z), DIN, 0, nullptr};
    pg8::gemm_phase<pg8::EpiBf16, pg8::StaticOrder, true, true>(cx.lds, g, S, E);
}
__device__ __forceinline__ void phase_outproj(const P& p, const Ctx& cx, int l) {
    pg8::Gemm g{(const bf16*)(p.ws + WS_M), (const bf16*)(p.ws + WS_WOUT) + (size_t)l * D * D, D, 0, 0};
    pg8::StaticOrder S; S.init(T, D, gridDim.x, blockIdx.x);
    float* xres = (float*)(p.ws + WS_XRES);
    pg8::EpiResidual E{l == 0 ? p.in[0] : xres, xres, (const float*)(p.ws + WS_MOD) + (size_t)l * 2 * 6144 + 2 * D, D, SEQ, 6144, 0};
    pg8::gemm_phase<pg8::EpiResidual, pg8::StaticOrder, true, true>(cx.lds, g, S, E);
}
__device__ __forceinline__ void phase_moe1(const P& p, const Ctx& cx, int l) {
    const int* tab = (const int*)(p.ws + WS_TAB);
    const int ntiles = __builtin_amdgcn_readfirstlane(__hip_atomic_load(tab, __ATOMIC_RELAXED, __HIP_MEMORY_SCOPE_AGENT));
    pg8::Gemm g{(const bf16*)(p.ws + WS_XB), (const bf16*)(p.ws + WS_WGU) + (size_t)l * NE * 2 * DFF * D, D, 0, (size_t)2 * DFF * D * 2};
    pg8::GroupedOrder S; S.init(ntiles, 2 * DFF / 256, gridDim.x, blockIdx.x, tab + 64);
    pg8::EpiBf16 E{(bf16*)(p.ws + WS_GU), 2 * DFF, 2 * DFF, p.in[15] + (size_t)l * NE * 2 * DFF};
    pg8::gemm_phase<pg8::EpiBf16, pg8::GroupedOrder, true, true>(cx.lds, g, S, E);
}
__device__ __forceinline__ void phase_moe2(const P& p, const Ctx& cx, int l) {
    const int* tab = (const int*)(p.ws + WS_TAB);
    const int ntiles = __builtin_amdgcn_readfirstlane(__hip_atomic_load(tab, __ATOMIC_RELAXED, __HIP_MEMORY_SCOPE_AGENT));
    pg8::Gemm g{(const bf16*)(p.ws + WS_ACT), (const bf16*)(p.ws + WS_WDN) + (size_t)l * NE * D * DFF, DFF, 0, (size_t)D * DFF * 2};
    pg8::GroupedOrder S; S.init(ntiles, D / 256, gridDim.x, blockIdx.x, tab + 64);
    pg8::EpiBf16 E{(bf16*)(p.ws + WS_Y), D, D, p.in[17] + (size_t)l * NE * D};
    pg8::gemm_phase<pg8::EpiBf16, pg8::GroupedOrder, true, true>(cx.lds, g, S, E);
}

enum { PH_PRO = 0, PH_N0, PH_N1, PH_NF, PH_INPROJ, PH_MIXER, PH_OUTPROJ, PH_ROUTER, PH_SCATTER, PH_GATHER, PH_MOE1, PH_ACT, PH_MOE2 };
template <int PH>
__global__ void __launch_bounds__(NTHREADS, 2) k_phase(P p, int l) {
    extern __shared__ __attribute__((aligned(16))) unsigned char lds_raw[];
    Ctx cx; cx.tid = threadIdx.x; cx.lane = cx.tid & 63; cx.wave = __builtin_amdgcn_readfirstlane(cx.tid >> 6); cx.gw = blockIdx.x * NWAVES + cx.wave; cx.ngw = gridDim.x * NWAVES; cx.lds = (LAS unsigned char*)lds_raw;
    if constexpr (PH == PH_PRO) phase_prologue(p, cx);
    if constexpr (PH == PH_N0) phase_norm1<0>(p, cx, l);
    if constexpr (PH == PH_N1) phase_norm1<1>(p, cx, l);
    if constexpr (PH == PH_NF) phase_norm1<2>(p, cx, l);
    if constexpr (PH == PH_INPROJ) phase_inproj(p, cx, l);
    if constexpr (PH == PH_MIXER) phase_mixer(p, cx, l);
    if constexpr (PH == PH_OUTPROJ) phase_outproj(p, cx, l);
    if constexpr (PH == PH_ROUTER) phase_router(p, cx, l);
    if constexpr (PH == PH_SCATTER) phase_scatter(p, cx);
    if constexpr (PH == PH_GATHER) phase_gather(p, cx);
    if constexpr (PH == PH_MOE1) phase_moe1(p, cx, l);
    if constexpr (PH == PH_ACT) phase_act(p, cx);
    if constexpr (PH == PH_MOE2) phase_moe2(p, cx, l);
}

template <int PH> static void launch_phase(const P& p, int l, int grid, hipStream_t stream) {
    static bool attr = false;
    if (!attr) { (void)hipFuncSetAttribute((const void*)k_phase<PH>, hipFuncAttributeMaxDynamicSharedMemorySize, LDS_BYTES); attr = true; }
    hipLaunchKernelGGL((k_phase<PH>), dim3(grid), dim3(NTHREADS), LDS_BYTES, stream, p, l);
}

extern "C" void kernel_launch(void* const* d_in, const int* in_sizes, int n_in, void* d_out, int out_size, void* d_ws, size_t ws_size, hipStream_t stream) {
    static int grid = 0;
    if (grid == 0) {
        if (n_in != 19 || in_sizes[0] != T * D || out_size != T * D || ws_size < WS_END) { fprintf(stderr, "kernel_launch: unexpected shapes (n_in %d, in0 %d, out %d, ws %zu < %zu); nothing launched\n", n_in, n_in > 0 ? in_sizes[0] : -1, out_size, ws_size, (size_t)WS_END); grid = -1; return; }
        int dev = 0, cus = 0;
        if (hipGetDevice(&dev) != hipSuccess || hipDeviceGetAttribute(&cus, hipDeviceAttributeMultiprocessorCount, dev) != hipSuccess) { grid = -1; return; }
        grid = cus;
    }
    if (grid < 0) return;
    P p{};
    for (int i = 0; i < 19; ++i) p.in[i] = (const float*)d_in[i];
    p.out = (float*)d_out; p.ws = (unsigned char*)d_ws;
    (void)hipMemsetAsync((char*)d_ws + WS_CTL, 0, CTL_BYTES, stream);
    launch_phase<PH_PRO>(p, 0, grid, stream);
    for (int l = 0; l < NL; ++l) {
        if (l == 0) launch_phase<PH_N0>(p, l, grid, stream); else launch_phase<PH_N1>(p, l, grid, stream);
        launch_phase<PH_INPROJ>(p, l, grid, stream);
        launch_phase<PH_MIXER>(p, l, grid, stream);
        launch_phase<PH_OUTPROJ>(p, l, grid, stream);
        launch_phase<PH_ROUTER>(p, l, grid, stream);
        launch_phase<PH_SCATTER>(p, l, grid, stream);
        launch_phase<PH_GATHER>(p, l, grid, stream);
        launch_phase<PH_MOE1>(p, l, grid, stream);
        launch_phase<PH_ACT>(p, l, grid, stream);
        launch_phase<PH_MOE2>(p, l, grid, stream);
    }
    launch_phase<PH_NF>(p, NL, grid, stream);
}
```

```cpp
#include <hip/hip_runtime.h>
#include <cstdio>
#include <cstdint>

namespace pg8 {
#define PG8_LAS __attribute__((address_space(3)))
typedef unsigned short bf16_t;
typedef short bf16x8 __attribute__((ext_vector_type(8)));
typedef float f32x4 __attribute__((ext_vector_type(4)));
typedef float f32x2 __attribute__((ext_vector_type(2)));
typedef unsigned u32x4 __attribute__((ext_vector_type(4)));
typedef unsigned u32x2 __attribute__((ext_vector_type(2)));
constexpr int BM = 256, BK = 64, HALF = 128, HTB = HALF * BK * 2  , STAGE_BYTES = 8 * HTB, NXCD = 8, WGM = 8;
constexpr int TILE_OFF = STAGE_BYTES  , TOK_OFF = STAGE_BYTES + 4096  , BIAS_OFF = TOK_OFF + 8192  , ROWS_OFF = BIAS_OFF + 2048  ;

__host__ __device__ __forceinline__ int lds_byte(int r, int c) { const int st = (r >> 4) * 2 + (c >> 5), rr = r & 15, cc = c & 31, ob = rr * 64 + cc * 2; return st * 1024 + (ob ^ (((ob >> 9) & 1) << 5)); }
__host__ __device__ __forceinline__ void stage_rc(int b, int& R, int& C) { const int st = b / 1024, sb = b % 1024, swz = sb ^ (((sb >> 9) & 1) << 5); R = (st >> 1) * 16 + swz / 64; C = (st & 1) * 32 + (swz % 64) / 2; }
__host__ __device__ __forceinline__ int perm32(int rho) { const int n = rho >> 4, i = rho & 15; return 8 * (i >> 2) + 4 * n + (i & 3); }

typedef int i32x8 __attribute__((ext_vector_type(8)));
typedef int i32x4 __attribute__((ext_vector_type(4)));
__device__ __forceinline__ i32x8 cat8(bf16x8 lo, bf16x8 hi) { const i32x4 l = __builtin_bit_cast(i32x4, lo), h = __builtin_bit_cast(i32x4, hi); return __builtin_shufflevector(l, h, 0, 1, 2, 3, 4, 5, 6, 7); }
template <int O> __device__ __forceinline__ float xshfl(float v) {
    if constexpr (O < 32) return __builtin_bit_cast(float, __builtin_amdgcn_ds_swizzle(__builtin_bit_cast(int, v), (O << 10) | 0x1f));
    else { int l; asm volatile("v_mbcnt_lo_u32_b32 %0, -1, 0\n\tv_mbcnt_hi_u32_b32 %0, -1, %0" : "=v"(l)); return __builtin_bit_cast(float, __builtin_amdgcn_ds_bpermute((l ^ 32) << 2, __builtin_bit_cast(int, v))); }
}
struct Unit { int pm, pn, be; };
struct Gemm { const bf16_t* A; const bf16_t* Bt; int K; int pad; size_t bstride; };

struct StaticOrder {
    int nM, nN, nwg, G, c;
    __host__ __device__ void init(int M, int N, int G_, int c_) { nM = M / BM; nN = N / BM; nwg = nM * nN; G = G_; c = c_; }
    __host__ __device__ bool next(int i, Unit& u) const {
        const long L = (long)i * G + c; if (L >= nwg) return false;
        int wgid = (int)L; { const int q = nwg / NXCD, r = nwg % NXCD, xcd = wgid % NXCD, off = wgid / NXCD; wgid = (xcd < r ? xcd * (q + 1) : r * (q + 1) + (xcd - r) * q) + off; }
        const int nig = WGM * nN, gid = wgid / nig, fm = gid * WGM, gsz = (nM - fm) < WGM ? (nM - fm) : WGM;
        u.pm = fm + ((wgid % nig) % gsz); u.pn = (wgid % nig) / gsz; u.be = 0; return true;
    }
    __device__ __forceinline__ void a_ready(const Unit&) const {}
    __device__ __forceinline__ void done(const Unit&) const {}
    __device__ __forceinline__ void after_unit(int, int, int) const {}
    __device__ __forceinline__ void before_epi(int, int, int) const {}
};
constexpr float CV_SCALE = 64.0f;
struct CvJob { const float* gu; const float* dn; unsigned char* gu8; unsigned char* dn8; };
struct CvItem { const float* src; unsigned char* dst; int N; };
__device__ __forceinline__ CvItem cv_item(const CvJob& J, int gw, int j) {
    const bool gu = j < 8; const int it = gw + 2048 * j - (gu ? 0 : 16384);
    const int N = gu ? 2048 : 1024, ipm = gu ? 512 : 256, nblk = N / 32, K = 1024;
    const int mi = it / ipm, r = it % ipm, k0 = 128 * (r / nblk), n0 = 32 * (r % nblk);
    const int d0 = gu ? ((n0 & 1023) >> 7) * 256 + (n0 >> 10) * 128 + (n0 & 127) : n0;
    CvItem c; c.src = (gu ? J.gu : J.dn) + (size_t)mi * K * N + (size_t)k0 * N + n0; c.dst = (gu ? J.gu8 : J.dn8) + (size_t)mi * K * N + (size_t)d0 * K + k0; c.N = N; return c;
}
__device__ __forceinline__ void cv_slice1(const CvJob& J, int gw, int j, int lane) {
    const int ng = lane & 7, kq = lane >> 3;
    const CvItem I = cv_item(J, gw, j);
    f32x4 v[16];
    const float* wp = I.src + (size_t)(16 * kq) * I.N + 4 * ng;
#pragma unroll
    for (int i = 0; i < 16; ++i) v[i] = __builtin_nontemporal_load((const f32x4*)(wp + (size_t)i * I.N));
    unsigned char* dst = I.dst + (size_t)(4 * ng) * 1024 + 16 * kq;
#pragma unroll
    for (int c = 0; c < 4; ++c) { unsigned o[4];
#pragma unroll
        for (int t = 0; t < 4; ++t) { o[t] = 0u; o[t] = __builtin_amdgcn_cvt_pk_fp8_f32(v[4 * t][c] * CV_SCALE, v[4 * t + 1][c] * CV_SCALE, o[t], false); o[t] = __builtin_amdgcn_cvt_pk_fp8_f32(v[4 * t + 2][c] * CV_SCALE, v[4 * t + 3][c] * CV_SCALE, o[t], true); }
        __builtin_nontemporal_store((u32x4){o[0], o[1], o[2], o[3]}, (u32x4*)(dst + (size_t)c * 1024)); }
}
constexpr int CV_NI = 1, CV_NSL = 12;
struct InprojOrder : StaticOrder {
    CvJob job; int njobs; int gw0;
    int rot;
    __device__ bool next(int i, Unit& u) const { int ii = i; if (rot > 0 && i < 14) { const int half = i >= 7 ? 1 : 0, k = i - 7 * half; int kk = k + rot; kk = kk >= 7 ? kk - 7 : kk; ii = 7 * half + kk; } return StaticOrder::next(ii, u); }
    __device__ __forceinline__ void before_epi(int ui, int wid, int lane) const {
        if (ui >= CV_NSL * njobs) return;
        const int j0 = CV_NI * ui;
        cv_slice1(job, gw0 + wid, ui, lane);
    }
};

struct GroupedOrder {
    int nM, nN, nwg, G, c; const PG8_LAS int* tile_e;
    __device__ void init(int nM_, int nN_, int G_, int c_, const PG8_LAS int* te) { nM = nM_; nN = nN_; nwg = nM * nN; G = G_; c = c_; tile_e = te; }
    __device__ bool next(int i, Unit& u) const {
        const long L = (long)i * G + c; if (L >= nwg) return false;
        int wgid = (int)L; { const int q = nwg / NXCD, r = nwg % NXCD, xcd = wgid % NXCD, off = wgid / NXCD; wgid = (xcd < r ? xcd * (q + 1) : r * (q + 1) + (xcd - r) * q) + off; }
        const int nig = WGM * nN, gid = wgid / nig, fm = gid * WGM, gsz = (nM - fm) < WGM ? (nM - fm) : WGM;
        u.pm = fm + ((wgid % nig) % gsz); u.pn = (wgid % nig) / gsz;
        u.be = __builtin_amdgcn_readfirstlane(tile_e[u.pm]); return true;
    }
    __device__ __forceinline__ void a_ready(const Unit&) const {}
    __device__ __forceinline__ void done(const Unit&) const {}
    __device__ __forceinline__ void after_unit(int, int, int) const {}
    __device__ __forceinline__ void before_epi(int, int, int) const {}
};
__device__ __forceinline__ int moe_g0(int x, int nM) { return (x * nM + 63) >> 6; }
struct Moe1Order : GroupedOrder {
    unsigned* ploc; unsigned* ptop; volatile PG8_LAS unsigned* st; int post_ui;
    __device__ __forceinline__ void after_unit(int ui, int wid, int lane) const {
        if (ui != post_ui) return;
        asm volatile("s_waitcnt vmcnt(0)" ::: "memory");
        __builtin_amdgcn_s_barrier();
        if (wid == 0 && lane == 0) {
            const unsigned nloc = st[0], x = (unsigned)__builtin_amdgcn_s_getreg((3 << 11) | 20) & 0xFu;
            const unsigned old = __hip_atomic_fetch_add(ploc + 64 * x, 1u, __ATOMIC_RELAXED, __HIP_MEMORY_SCOPE_AGENT);
            if (old + 1u == nloc) { __builtin_amdgcn_fence(__ATOMIC_RELEASE, "agent"); asm volatile("s_waitcnt vmcnt(0)" ::: "memory"); (void)__hip_atomic_fetch_add(ptop, 1u, __ATOMIC_RELAXED, __HIP_MEMORY_SCOPE_AGENT); }
        }
    }
};
struct Moe2Order {
    int nM, nwg, G, c, nfree; const PG8_LAS int* tile_e;
    __device__ void init(int nM_, int G_, int c_, const PG8_LAS int* te, int nfree_) { nM = nM_; nfree = nfree_; nwg = nM * 4 - nfree_; G = G_; c = c_; tile_e = te; }
    __device__ bool next(int i, Unit& u) const {
        const long L = (long)i * G + c; if (L >= nwg) return false;
        int w = (int)L; { const int q = nwg / NXCD, r = nwg % NXCD, xcd = w % NXCD, off = w / NXCD; w = (xcd < r ? xcd * (q + 1) : r * (q + 1) + (xcd - r) * q) + off; }
#pragma unroll
        for (int x = 0; x < 8; ++x) { const int nx_ = nfree > x ? (nfree - x + 7) >> 3 : 0; if (w >= 32 * moe_g0(x, nM)) w += nx_; }
        const int gid = w / 32, fm = gid * WGM, gsz = (nM - fm) < WGM ? (nM - fm) : WGM;
        u.pm = fm + ((w % 32) % gsz); u.pn = (w % 32) / gsz;
        u.be = __builtin_amdgcn_readfirstlane(tile_e[u.pm]); return true;
    }
    __device__ __forceinline__ void a_ready(const Unit&) const {}
    __device__ __forceinline__ void done(const Unit&) const {}
    __device__ __forceinline__ void after_unit(int, int, int) const {}
    __device__ __forceinline__ void before_epi(int, int, int) const {}
};
struct EarlyOrder {
    int pm, pn, be;
    __device__ bool next(int i, Unit& u) const { if (i != 0) return false; u.pm = pm; u.pn = pn; u.be = be; return true; }
    __device__ __forceinline__ void a_ready(const Unit&) const {}
    __device__ __forceinline__ void done(const Unit&) const {}
    __device__ __forceinline__ void after_unit(int, int, int) const {}
    __device__ __forceinline__ void before_epi(int, int, int) const {}
};

__device__ __forceinline__ unsigned cvt_pk_bf16(float lo, float hi) { unsigned r; asm volatile("v_cvt_pk_bf16_f32 %0, %1, %2" : "=v"(r) : "v"(lo), "v"(hi)); return r; }

struct EpiFp8Out {
    static constexpr bool PERM = true, AFTER_DRAIN = false, HAS_BIAS = true, HAS_ROWSCALE = false;
    unsigned char* O; int ldc; int bias_stride; const float* bias; float scale, oscale;
    __device__ __forceinline__ const float* rowscale_ptr(const Unit&, int, int, int) const { return nullptr; }
    __device__ __forceinline__ const float* bias_ptr(const Unit& u, int wc, int lane) const { return bias + (size_t)u.be * bias_stride + u.pn * BM + (lane >> 5) * HALF + wc * 32 + (lane & 31); }
    __device__ __forceinline__ void operator()(const f32x4 (&acc)[2][2][4][2], const Unit& u, int wr, int wc, int fr, int fq, const PG8_LAS float* bl, const PG8_LAS float*) const {
        const int row0 = u.pm * BM + wr * 64 + fr; const int col0 = u.pn * BM + wc * 32 + 8 * fq;
        f32x4 bv[2][2]; const float so = scale * oscale;
#pragma unroll
        for (int bj = 0; bj < 2; ++bj)
#pragma unroll
            for (int n = 0; n < 2; ++n) bv[bj][n] = *(const PG8_LAS f32x4*)(bl + 32 * bj + 8 * fq + 4 * n) * oscale;
#pragma unroll
        for (int ai = 0; ai < 2; ++ai)
#pragma unroll
            for (int m = 0; m < 4; ++m) { unsigned char* rowp = O + (size_t)(row0 + ai * HALF + m * 16) * ldc + col0;
#pragma unroll
                for (int bj = 0; bj < 2; ++bj) { const f32x4 v0 = acc[ai][bj][m][0] * so + bv[bj][0], v1 = acc[ai][bj][m][1] * so + bv[bj][1];
                    u32x2 w; w.x = 0u; w.y = 0u;
                    w.x = __builtin_amdgcn_cvt_pk_fp8_f32(v0[0], v0[1], w.x, false); w.x = __builtin_amdgcn_cvt_pk_fp8_f32(v0[2], v0[3], w.x, true);
                    w.y = __builtin_amdgcn_cvt_pk_fp8_f32(v1[0], v1[1], w.y, false); w.y = __builtin_amdgcn_cvt_pk_fp8_f32(v1[2], v1[3], w.y, true);
                    *(u32x2*)(rowp + bj * HALF) = w; } }
    }
};
template <bool BASE32>
struct EpiResidual {
    static constexpr bool PERM = true, AFTER_DRAIN = false, HAS_BIAS = false, HAS_ROWSCALE = false;
    const void* base; bf16_t* out; const float* gate; float* ssq; int ldc; int rows_per_batch; int gate_stride; int pad;
    __device__ __forceinline__ const float* rowscale_ptr(const Unit&, int, int, int) const { return nullptr; }
    __device__ __forceinline__ const float* bias_ptr(const Unit&, int, int) const { return nullptr; }
    __device__ __forceinline__ void operator()(const f32x4 (&acc)[2][2][4][2], const Unit& u, int wr, int wc, int fr, int fq, const PG8_LAS float*, const PG8_LAS float*) const {
        const int row0 = u.pm * BM + wr * 64 + fr, col0 = u.pn * BM + wc * 32 + 8 * fq;
        const float* gp = gate + (size_t)((u.pm * BM) / rows_per_batch) * gate_stride;
        f32x4 gv[2][2];
#pragma unroll
        for (int bj = 0; bj < 2; ++bj)
#pragma unroll
            for (int n = 0; n < 2; ++n) gv[bj][n] = *(const f32x4*)(gp + col0 + bj * HALF + 4 * n);
#pragma unroll
        for (int ai = 0; ai < 2; ++ai) {
          u32x4 qb[4][2];
          if (!BASE32) {
#pragma unroll
            for (int m = 0; m < 4; ++m)
#pragma unroll
                for (int bj = 0; bj < 2; ++bj) qb[m][bj] = *(const u32x4*)((const bf16_t*)base + (size_t)(row0 + ai * HALF + m * 16) * ldc + col0 + bj * HALF);
          }
#pragma unroll
            for (int m = 0; m < 4; ++m) { const int row = row0 + ai * HALF + m * 16; const size_t off = (size_t)row * ldc + col0; float s = 0.f;
#pragma unroll
                for (int bj = 0; bj < 2; ++bj) { f32x4 b0, b1;
                    if (BASE32) { b0 = *(const f32x4*)((const float*)base + off + bj * HALF); b1 = *(const f32x4*)((const float*)base + off + bj * HALF + 4); }
                    else { const u32x4 q = qb[m][bj];
                        b0 = (f32x4){__builtin_bit_cast(float, q.x << 16), __builtin_bit_cast(float, q.x & 0xffff0000u), __builtin_bit_cast(float, q.y << 16), __builtin_bit_cast(float, q.y & 0xffff0000u)};
                        b1 = (f32x4){__builtin_bit_cast(float, q.z << 16), __builtin_bit_cast(float, q.z & 0xffff0000u), __builtin_bit_cast(float, q.w << 16), __builtin_bit_cast(float, q.w & 0xffff0000u)}; }
                    const f32x4 o0 = b0 + gv[bj][0] * acc[ai][bj][m][0], o1 = b1 + gv[bj][1] * acc[ai][bj][m][1];
                    s += ((o0[0] * o0[0] + o0[1] * o0[1]) + (o0[2] * o0[2] + o0[3] * o0[3])) + ((o1[0] * o1[0] + o1[1] * o1[1]) + (o1[2] * o1[2] + o1[3] * o1[3]));
                    u32x4 w; w.x = cvt_pk_bf16(o0[0], o0[1]); w.y = cvt_pk_bf16(o0[2], o0[3]); w.z = cvt_pk_bf16(o1[0], o1[1]); w.w = cvt_pk_bf16(o1[2], o1[3]);
                    *(u32x4*)(out + off + bj * HALF) = w; }
                s += xshfl<16>(s); s += xshfl<32>(s);
                if (fq == 0) ssq[(size_t)row * 16 + u.pn * 4 + wc] = s;
                if (BASE32) asm volatile("" ::: "memory"); }
          asm volatile("" ::: "memory");
        }
    }
};

struct EpiSwiglu {
    static constexpr bool PERM = true, AFTER_DRAIN = false, HAS_BIAS = true, HAS_ROWSCALE = false;
    unsigned char* O; int ldc; int bias_stride; const float* bias; float iscale, oscale;
    __device__ __forceinline__ const float* rowscale_ptr(const Unit&, int, int, int) const { return nullptr; }
    __device__ __forceinline__ const float* bias_ptr(const Unit& u, int wc, int lane) const { return bias + (size_t)u.be * bias_stride + (lane >> 5) * ldc + u.pn * HALF + wc * 32 + (lane & 31); }
    __device__ __forceinline__ void operator()(const f32x4 (&acc)[2][2][4][2], const Unit& u, int wr, int wc, int fr, int fq, const PG8_LAS float* bl, const PG8_LAS float*) const {
        const int row0 = u.pm * BM + wr * 64 + fr; const int col0 = u.pn * HALF + wc * 32 + 8 * fq;
        f32x4 bg[2], bu[2];
#pragma unroll
        for (int n = 0; n < 2; ++n) { bg[n] = *(const PG8_LAS f32x4*)(bl + 8 * fq + 4 * n); bu[n] = *(const PG8_LAS f32x4*)(bl + 32 + 8 * fq + 4 * n); }
#pragma unroll
        for (int ai = 0; ai < 2; ++ai)
#pragma unroll
            for (int m = 0; m < 4; ++m) { unsigned char* rowp = O + (size_t)(row0 + ai * HALF + m * 16) * ldc + col0; float r[8];
#pragma unroll
                for (int n = 0; n < 2; ++n) { const f32x4 gv = acc[ai][0][m][n] * iscale + bg[n], uv = acc[ai][1][m][n] * iscale + bu[n];
#pragma unroll
                    for (int j = 0; j < 4; ++j) { const float gt = fminf(gv[j], 7.0f), up = fminf(fmaxf(uv[j], -7.0f), 7.0f);
                        r[4 * n + j] = gt * __builtin_amdgcn_rcpf(1.0f + __builtin_amdgcn_exp2f(gt * (-1.702f * 1.44269504f))) * __builtin_fmaf(up, oscale, oscale); } }
                u32x2 w; w.x = 0u; w.y = 0u;
                w.x = __builtin_amdgcn_cvt_pk_fp8_f32(r[0], r[1], w.x, false); w.x = __builtin_amdgcn_cvt_pk_fp8_f32(r[2], r[3], w.x, true);
                w.y = __builtin_amdgcn_cvt_pk_fp8_f32(r[4], r[5], w.y, false); w.y = __builtin_amdgcn_cvt_pk_fp8_f32(r[6], r[7], w.y, true);
                *(u32x2*)rowp = w; }
    }
};

__device__ __forceinline__ f32x2 gelu_pk(f32x2 v) {
    const f32x2 av = __builtin_elementwise_abs(v), d = av * 0.2316418882f + 1.0f;
    f32x2 t; t.x = __builtin_amdgcn_rcpf(d.x); t.y = __builtin_amdgcn_rcpf(d.y);
    f32x2 q = t * 0.5307027145f + (-0.7265760135f); q = q * t + 0.7107068705f; q = q * t + (-0.142248368f); q = q * t + 0.127414796f; q = q * t;
    const f32x2 s = (v * v) * (-0.72134752044f);
    f32x2 e; e.x = __builtin_amdgcn_exp2f(s.x); e.y = __builtin_amdgcn_exp2f(s.y);
    const f32x2 qe = q * e; f32x2 mx; mx.x = fmaxf(v.x, 0.f); mx.y = fmaxf(v.y, 0.f);
    return mx - av * qe;
}
__device__ __forceinline__ f32x4 gelu4(f32x4 v) { const f32x2 a = gelu_pk((f32x2){v[0], v[1]}), b = gelu_pk((f32x2){v[2], v[3]}); return (f32x4){a.x, a.y, b.x, b.y}; }
__device__ __forceinline__ f32x4 sigmoid4n(f32x4 t) { f32x4 o;
#pragma unroll
    for (int j = 0; j < 4; ++j) o[j] = __builtin_amdgcn_rcpf(1.0f + __builtin_amdgcn_exp2f(t[j])); return o; }

struct EpiMix {
    static constexpr bool PERM = true, AFTER_DRAIN = false, HAS_BIAS = true, HAS_ROWSCALE = true;
    bf16_t* O; size_t plane; int ldc; int pad; f32x2* vst;
    const float* rowscale; const float* colscale;
    __device__ __forceinline__ const float* rowscale_ptr(const Unit& u, int ai, int wr, int lane) const { return rowscale + u.pm * BM + ai * HALF + wr * 64 + lane; }
    __device__ __forceinline__ const float* bias_ptr(const Unit& u, int wc, int lane) const { return colscale + u.pn * BM + (lane >> 5) * HALF + wc * 32 + (lane & 31); }
    static __device__ __forceinline__ f32x4 deq(const f32x4 a, const float sr, const f32x4 sc) { const i32x4 i = __builtin_bit_cast(i32x4, a); return (f32x4){(float)i[0], (float)i[1], (float)i[2], (float)i[3]} * sr * sc; }
    __device__ __forceinline__ void operator()(const f32x4 (&acc)[2][2][4][2], const Unit& u, int wr, int wc, int fr, int fq, const PG8_LAS float* bl, const PG8_LAS float* rs) const {
        const int row0 = u.pm * BM + wr * 64 + fr, lc = wc * 32 + 8 * fq, ty = u.pn >> 3;
        f32x4 sc[2][2];
#pragma unroll
        for (int bj = 0; bj < 2; ++bj)
#pragma unroll
            for (int n = 0; n < 2; ++n) sc[bj][n] = *(const PG8_LAS f32x4*)(bl + 32 * bj + 8 * fq + 4 * n);
        if (ty == 1 || ty == 2) { sc[1][0] = sc[1][0] * -1.44269504f; sc[1][1] = sc[1][1] * -1.44269504f; }
        if (ty < 3) {
            bf16_t* base = O + (size_t)ty * plane + (u.pn & 7) * HALF + lc;
#pragma unroll
            for (int ai = 0; ai < 2; ++ai)
#pragma unroll
                for (int m = 0; m < 4; ++m) { bf16_t* rowp = base + (size_t)(row0 + ai * HALF + m * 16) * ldc; f32x4 r[2];
#pragma unroll
                    for (int n = 0; n < 2; ++n) { const float sr = rs[ai * 64 + m * 16 + fr]; const f32x4 x0 = deq(acc[ai][0][m][n], sr, sc[0][n]), x1 = deq(acc[ai][1][m][n], sr, sc[1][n]);
                        if (ty == 0) r[n] = x0 * x1; else if (ty == 1) r[n] = x0 * sigmoid4n(x1); else r[n] = gelu4(x0) * sigmoid4n(x1); }
                    u32x4 w; w.x = cvt_pk_bf16(r[0][0], r[0][1]); w.y = cvt_pk_bf16(r[0][2], r[0][3]); w.z = cvt_pk_bf16(r[1][0], r[1][1]); w.w = cvt_pk_bf16(r[1][2], r[1][3]);
                    *(u32x4*)rowp = w; }
        } else {
            bf16_t* base = O + (size_t)3 * plane + (u.pn - 24) * BM + lc;
#pragma unroll
            for (int ai = 0; ai < 2; ++ai)
#pragma unroll
                for (int m = 0; m < 4; ++m) { const int row = row0 + ai * HALF + m * 16; bf16_t* rowp = base + (size_t)row * ldc; float s = 0.f, q = 0.f;
#pragma unroll
                    for (int bj = 0; bj < 2; ++bj) { const float sr = rs[ai * 64 + m * 16 + fr]; const f32x4 g0 = gelu4(deq(acc[ai][bj][m][0], sr, sc[bj][0])), g1 = gelu4(deq(acc[ai][bj][m][1], sr, sc[bj][1]));
                        s += ((g0[0] + g0[1]) + (g0[2] + g0[3])) + ((g1[0] + g1[1]) + (g1[2] + g1[3]));
                        q += ((g0[0] * g0[0] + g0[1] * g0[1]) + (g0[2] * g0[2] + g0[3] * g0[3])) + ((g1[0] * g1[0] + g1[1] * g1[1]) + (g1[2] * g1[2] + g1[3] * g1[3]));
                        u32x4 w; w.x = cvt_pk_bf16(g0[0], g0[1]); w.y = cvt_pk_bf16(g0[2], g0[3]); w.z = cvt_pk_bf16(g1[0], g1[1]); w.w = cvt_pk_bf16(g1[2], g1[3]);
                        *(u32x4*)(rowp + bj * HALF) = w; }
                    s += xshfl<16>(s); s += xshfl<32>(s); q += xshfl<16>(q); q += xshfl<32>(q);
                    if (fq == 0) vst[(size_t)row * 16 + (u.pn - 24) * 4 + wc] = (f32x2){s, q}; }
        }
    }
};

template <class Epi, class Sched, bool GATHER, int OPK = 0>
__device__ __forceinline__ void gemm_phase(PG8_LAS unsigned char* lds, const Gemm g, const Sched& S, const Epi& E, const int* rowtok, int wv_) {
    asm volatile("" : "+s"(wv_)); int lane_; asm volatile("v_mbcnt_lo_u32_b32 %0, -1, 0\n\tv_mbcnt_hi_u32_b32 %0, -1, %0" : "=v"(lane_)); int tid_ = wv_ * 64 + lane_; asm volatile("" : "+v"(tid_));
    constexpr bool FP8 = (OPK == 1), I8 = (OPK == 2);
    const int tid = tid_, wid = __builtin_amdgcn_readfirstlane(tid >> 6), lane = tid & 63, wr = wid >> 2, wc = wid & 3, fr = lane & 15, fq = lane >> 4;
    const int K = g.K, rowb = (OPK != 0) ? K : K * 2  , nt = rowb / (BK * 2);
    const size_t kstep = (size_t)(BK * 2);
    const size_t hstep = (size_t)HALF * rowb;
    const size_t tstep = 2 * hstep;
    unsigned voffB[2], voA[2][2]; int RA[2]; unsigned CA[2];
#pragma unroll
    for (int i = 0; i < 2; ++i) { int R, C; stage_rc(tid * 16 + i * 8192, R, C); const int Rb = Epi::PERM ? ((R & ~31) + perm32(R & 31)) : R;
        voffB[i] = (unsigned)(Rb * rowb + C * 2); RA[i] = R; CA[i] = (unsigned)C * 2u;
        voA[0][i] = (unsigned)(R * rowb + C * 2); voA[1][i] = voA[0][i] + (unsigned)hstep; }
    const unsigned ldsw = (unsigned)wid * 1024u;
    const int aoff = FP8 ? lds_byte(wr * 64 + fr, fq * 16) : lds_byte(wr * 64 + fr, fq * 8), boff = FP8 ? lds_byte(wc * 32 + fr, fq * 16) : lds_byte(wc * 32 + fr, fq * 8);
#define PG8_SA(b, h) (((b) * 2 + (h)) * HTB)
#define PG8_SB(b, h) ((4 + (b) * 2 + (h)) * HTB)
#define PG8_STAGE(bufoff, gbase, voff) do { _Pragma("unroll") for (int _i = 0; _i < 2; ++_i) \
        __builtin_amdgcn_global_load_lds((const unsigned*)((const char*)(gbase) + (voff)[_i]), (PG8_LAS unsigned*)(lds + (bufoff) + ldsw + _i * 8192), 16, 0, 0); } while (0)
#define PG8_LD8(dst, off) do { const i32x4 lo_ = *(const PG8_LAS i32x4*)(lds + (off)), hi_ = *(const PG8_LAS i32x4*)(lds + (off) + 16); dst = __builtin_shufflevector(lo_, hi_, 0, 1, 2, 3, 4, 5, 6, 7); } while (0)
#define PG8_LDA(dst, b, h) do { if constexpr (FP8) { _Pragma("unroll") for (int m = 0; m < 4; ++m) PG8_LD8(dst##8[m], PG8_SA(b, h) + aoff + m * 2048); } else { \
        _Pragma("unroll") for (int m = 0; m < 4; ++m) _Pragma("unroll") for (int k = 0; k < 2; ++k) dst[m][k] = *(const PG8_LAS bf16x8*)(lds + PG8_SA(b, h) + aoff + m * 2048 + k * 1024); } } while (0)
#define PG8_LDB(dst, b, h) do { if constexpr (FP8) { _Pragma("unroll") for (int n = 0; n < 2; ++n) PG8_LD8(dst##8[n], PG8_SB(b, h) + boff + n * 2048); } else { \
        _Pragma("unroll") for (int n = 0; n < 2; ++n) _Pragma("unroll") for (int k = 0; k < 2; ++k) dst[n][k] = *(const PG8_LAS bf16x8*)(lds + PG8_SB(b, h) + boff + n * 2048 + k * 1024); } } while (0)
#define PG8_MMA(ai, bj, At, Bt) do { __builtin_amdgcn_s_setprio(1); if constexpr (FP8) { _Pragma("unroll") for (int m = 0; m < 4; ++m) _Pragma("unroll") for (int n = 0; n < 2; ++n) \
        asm volatile("v_mfma_scale_f32_16x16x128_f8f6f4 %0, %1, %2, %0, %3, %3 op_sel_hi:[0,0,0]" : "+v"(acc[ai][bj][m][n]) : "v"(Bt##8[n]), "v"(At##8[m]), "v"(one8)); } \
        else if constexpr (I8) { _Pragma("unroll") for (int m = 0; m < 4; ++m) _Pragma("unroll") for (int n = 0; n < 2; ++n) _Pragma("unroll") for (int k = 0; k < 2; ++k) \
        acc[ai][bj][m][n] = __builtin_bit_cast(f32x4, __builtin_amdgcn_mfma_i32_16x16x64_i8(__builtin_bit_cast(i32x4, Bt[n][k]), __builtin_bit_cast(i32x4, At[m][k]), __builtin_bit_cast(i32x4, acc[ai][bj][m][n]), 0, 0, 0)); } \
        else { _Pragma("unroll") for (int m = 0; m < 4; ++m) _Pragma("unroll") for (int n = 0; n < 2; ++n) _Pragma("unroll") for (int k = 0; k < 2; ++k) \
        acc[ai][bj][m][n] = __builtin_amdgcn_mfma_f32_16x16x32_bf16(Bt[n][k], At[m][k], acc[ai][bj][m][n], 0, 0, 0); } __builtin_amdgcn_s_setprio(0); } while (0)
#define PG8_WAIT_V(n) asm volatile("s_waitcnt vmcnt(" #n ")" ::: "memory")
#define PG8_WAIT_L(n) asm volatile("s_waitcnt lgkmcnt(" #n ")" ::: "memory")
#define PG8_BAR __builtin_amdgcn_s_barrier()
#define PG8_SCHED __builtin_amdgcn_sched_barrier(0)
#define PG8_TOKLOAD(pm_) do { _Pragma("unroll") for (int _h = 0; _h < 2; ++_h) _Pragma("unroll") for (int _i = 0; _i < 2; ++_i) \
        __builtin_amdgcn_global_load_lds((const unsigned*)(rowtok + (size_t)(pm_) * BM + _h * HALF + RA[_i]), (PG8_LAS unsigned*)(lds + TOK_OFF + wid * 1024 + (_h * 2 + _i) * 256), 4, 0, 0); } while (0)
#define PG8_TOKREAD(dst) do { _Pragma("unroll") for (int _h = 0; _h < 2; ++_h) _Pragma("unroll") for (int _i = 0; _i < 2; ++_i) \
        dst[_h][_i] = (unsigned)(*(const PG8_LAS int*)(lds + TOK_OFF + wid * 1024 + (_h * 2 + _i) * 256 + lane * 4)) * (unsigned)rowb + CA[_i]; } while (0)
#define PG8_BIASLOAD(u_) do { if constexpr (Epi::HAS_BIAS) { int lb_ = lane; asm volatile("" : "+v"(lb_));     \
        __builtin_amdgcn_global_load_lds((const unsigned*)E.bias_ptr(u_, wc, lb_), (PG8_LAS unsigned*)(lds + BIAS_OFF + wid * 256), 4, 0, 0); } } while (0)
#define PG8_ROWSLOAD(u_) do { if constexpr (Epi::HAS_ROWSCALE) { int lr_ = lane; asm volatile("" : "+v"(lr_)); _Pragma("unroll") for (int _ai = 0; _ai < 2; ++_ai) \
        __builtin_amdgcn_global_load_lds((const unsigned*)E.rowscale_ptr(u_, _ai, wr, lr_), (PG8_LAS unsigned*)(lds + ROWS_OFF + wid * 512 + _ai * 256), 4, 0, 0); } } while (0)
    Unit cur, nxt; int ui = 0;
    if (!S.next(0, cur)) return;
    f32x4 acc[2][2][4][2];
#pragma unroll
    for (int a = 0; a < 2; ++a)
#pragma unroll
        for (int b = 0; b < 2; ++b)
#pragma unroll
            for (int m = 0; m < 4; ++m)
#pragma unroll
                for (int n = 0; n < 2; ++n) acc[a][b][m][n] = (f32x4){0.f, 0.f, 0.f, 0.f};
    int one8 = 0x7f7f7f7f; asm volatile("" : "+v"(one8));
    bf16x8 At[4][2], B0[2][2], B1[2][2]; i32x8 At8[4], B08[2], B18[2];
    if constexpr (GATHER) { PG8_TOKLOAD(cur.pm); asm volatile("s_waitcnt vmcnt(0)" ::: "memory"); PG8_TOKREAD(voA); }
    const char* cA = GATHER ? (const char*)g.A : (const char*)g.A + (size_t)cur.pm * tstep; const char* cB = (const char*)g.Bt + (size_t)cur.be * g.bstride + (size_t)cur.pn * tstep;
    S.a_ready(cur);
    PG8_BIASLOAD(cur); PG8_ROWSLOAD(cur);
    PG8_STAGE(PG8_SB(0, 0), cB, voffB); PG8_STAGE(PG8_SB(0, 1), cB + hstep, voffB); PG8_STAGE(PG8_SA(0, 0), cA, voA[0]); PG8_STAGE(PG8_SA(0, 1), cA, voA[1]);
    if (wr == 1) PG8_BAR;
    PG8_WAIT_V(2); PG8_BAR;
    PG8_STAGE(PG8_SB(1, 0), cB + kstep, voffB); PG8_STAGE(PG8_SA(1, 0), cA + kstep, voA[0]); PG8_STAGE(PG8_SB(1, 1), cB + hstep + kstep, voffB);
    PG8_WAIT_V(6); PG8_BAR;
    for (;;) {
        const bool has_next = S.next(ui + 1, nxt);
        const char* nA = (has_next && !GATHER) ? (const char*)g.A + (size_t)nxt.pm * tstep : cA; const char* nB = has_next ? (const char*)g.Bt + (size_t)nxt.be * g.bstride + (size_t)nxt.pn * tstep : cB;
        if constexpr (GATHER) { if (has_next) PG8_TOKLOAD(nxt.pm); }
#pragma unroll 1
        for (int t = 0; t < nt; t += 2) {
            const bool last = (t == nt - 2);
            const char* a1 = cA + (size_t)(t + 1) * kstep;
            const char* a2 = last ? nA : cA + (size_t)(t + 2) * kstep; const char* b2 = last ? nB : cB + (size_t)(t + 2) * kstep;
            const char* a3 = a2 + kstep; const char* b3 = b2 + kstep;
            if (last && has_next) S.a_ready(nxt);
            unsigned vo2[2][2];
#pragma unroll
            for (int h = 0; h < 2; ++h)
#pragma unroll
                for (int i = 0; i < 2; ++i) vo2[h][i] = voA[h][i];
            if constexpr (GATHER) { if (last && has_next) { PG8_TOKREAD(vo2); } }
            PG8_LDB(B0, 0, 0); PG8_LDB(B1, 0, 1); PG8_SCHED; PG8_LDA(At, 0, 0); PG8_STAGE(PG8_SA(1, 1), a1, voA[1]);
            PG8_WAIT_V(8); PG8_WAIT_L(0); PG8_BAR; PG8_MMA(0, 0, At, B0); PG8_MMA(0, 1, At, B1); PG8_BAR; PG8_SCHED;
            PG8_LDA(At, 0, 1); PG8_STAGE(PG8_SB(0, 0), b2, voffB); PG8_STAGE(PG8_SB(0, 1), b2 + hstep, voffB); PG8_STAGE(PG8_SA(0, 0), a2, vo2[0]);
            PG8_WAIT_V(8); PG8_WAIT_L(0); PG8_BAR; PG8_MMA(1, 0, At, B0); PG8_MMA(1, 1, At, B1); PG8_BAR; PG8_SCHED;
            PG8_LDB(B0, 1, 0); PG8_LDB(B1, 1, 1); PG8_SCHED; PG8_LDA(At, 1, 0); PG8_STAGE(PG8_SA(0, 1), a2, vo2[1]);
            PG8_WAIT_V(8); PG8_WAIT_L(0); PG8_BAR; PG8_MMA(0, 0, At, B0); PG8_MMA(0, 1, At, B1); PG8_BAR; PG8_SCHED;
            PG8_LDA(At, 1, 1); PG8_STAGE(PG8_SB(1, 0), b3, voffB); PG8_STAGE(PG8_SB(1, 1), b3 + hstep, voffB); PG8_STAGE(PG8_SA(1, 0), a3, vo2[0]);
            PG8_WAIT_V(8); PG8_WAIT_L(0); PG8_BAR; PG8_MMA(1, 0, At, B0); PG8_MMA(1, 1, At, B1); PG8_BAR; PG8_SCHED;
        }
        if constexpr (FP8) asm volatile("s_nop 15\n\ts_nop 15" ::: "memory");
        if (wr == 0) PG8_BAR;
        S.before_epi(ui, wid, lane);
        if constexpr (!Epi::AFTER_DRAIN) { E(acc, cur, wr, wc, fr, fq, (const PG8_LAS float*)(lds + BIAS_OFF + wid * 256), (const PG8_LAS float*)(lds + ROWS_OFF + wid * 512)); S.done(cur); S.after_unit(ui, wid, lane); }
        if (!has_next) break;
#pragma unroll
        for (int a = 0; a < 2; ++a)
#pragma unroll
            for (int b = 0; b < 2; ++b)
#pragma unroll
                for (int m = 0; m < 4; ++m)
#pragma unroll
                    for (int n = 0; n < 2; ++n) acc[a][b][m][n] = (f32x4){0.f, 0.f, 0.f, 0.f};
        cur = nxt; cA = nA; cB = nB; ++ui;
        PG8_BIASLOAD(cur); PG8_ROWSLOAD(cur);
        if constexpr (GATHER) { PG8_TOKREAD(voA); }
        if (wr == 1) PG8_BAR;
    }
    PG8_WAIT_V(0);
    PG8_BAR;
#undef PG8_SA
#undef PG8_SB
#undef PG8_STAGE
#undef PG8_LDA
#undef PG8_LD8
#undef PG8_LDB
#undef PG8_MMA
#undef PG8_WAIT_V
#undef PG8_WAIT_L
#undef PG8_BAR
#undef PG8_SCHED
#undef PG8_TOKLOAD
#undef PG8_BIASLOAD
#undef PG8_ROWSLOAD
#undef PG8_TOKREAD
}
}

#define LAS __attribute__((address_space(3)))
typedef unsigned short bf16;
typedef float f32x4 __attribute__((ext_vector_type(4)));
typedef unsigned u32x4 __attribute__((ext_vector_type(4)));
typedef unsigned u32x2 __attribute__((ext_vector_type(2)));
constexpr int NB = 2, SEQ = 16384, T = NB * SEQ, D = 1024, DIN = 7168, NE = 32, TOPK = 4, DFF = 1024, NL = 4, CHK = 128, NG = 8;
constexpr int NCHUNK = T / CHK;
constexpr int NASSIGN = T * TOPK;
constexpr int NTILE_MAX = NASSIGN / 256 + NE;
constexpr int NROW_MAX = NTILE_MAX * 256;
constexpr float EPS = 1e-6f;
constexpr float WSCALE = 64.0f, ASCALE = 4.0f, YSCALE = 8.0f; static_assert(WSCALE == pg8::CV_SCALE, "one weight pre-scale");
constexpr int NWAVES = 8, NTHREADS = 512;
constexpr int LDS_BYTES = 163840;

constexpr size_t al4k(size_t x) { return (x + 4095) & ~(size_t)4095; }
constexpr size_t WS_CTL = 0, CTL_BYTES = 1u << 20;
constexpr size_t WS_MOD = WS_CTL + CTL_BYTES;
constexpr size_t WS_RTH = WS_MOD + al4k((size_t)NL * 2 * 6144 * 4);
constexpr size_t WS_RTL = WS_RTH + al4k((size_t)NL * NE * D * 2);
constexpr size_t WS_SSQ = WS_RTL + al4k((size_t)NL * NE * D * 2);
constexpr size_t WS_CNT = WS_SSQ + al4k((size_t)T * 16 * 4);
constexpr size_t WS_TAB = WS_CNT + al4k((size_t)NCHUNK * NE * 4);
constexpr size_t WS_AE = WS_TAB + al4k(4096);
constexpr size_t WS_AR = WS_AE + al4k((size_t)NASSIGN * 4);
constexpr size_t WS_AW = WS_AR + al4k((size_t)NASSIGN * 4);
constexpr size_t WS_AROW = WS_AW + al4k((size_t)NASSIGN * 4);
constexpr size_t WS_ROWTOK = WS_AROW + al4k((size_t)NASSIGN * 4);
constexpr size_t WS_WIN = WS_ROWTOK + al4k((size_t)NROW_MAX * 4);
constexpr size_t WS_WOUT = WS_WIN + al4k((size_t)NL * DIN * D * 2);
constexpr size_t WS_WGU = WS_WOUT + al4k((size_t)NL * D * D * 2);
constexpr size_t WS_WDN = WS_WGU + al4k((size_t)NL * NE * 2 * DFF * D);
constexpr size_t WS_H8 = WS_WDN + al4k((size_t)NL * NE * D * DFF);
constexpr size_t WS_XRES = WS_H8 + al4k((size_t)T * D);
constexpr size_t WS_H = WS_XRES + al4k((size_t)T * D * 2);
constexpr size_t WS_Z = WS_H + al4k((size_t)T * D * 2);
constexpr size_t WS_VST = WS_Z + al4k((size_t)4 * T * D * 2);
constexpr size_t WS_WSB = WS_VST + al4k((size_t)T * 16 * 8);
constexpr size_t WS_HS = WS_WSB + al4k((size_t)NL * NG * CHK * CHK * 2);
constexpr size_t WS_WSC = WS_HS + al4k((size_t)T * 4);
constexpr size_t WS_M = WS_WSC + al4k((size_t)NL * DIN * 4);
constexpr size_t WS_XB = WS_M + al4k((size_t)T * D * 2);
constexpr size_t WS_GU = WS_XB + al4k((size_t)NROW_MAX * D * 2);
constexpr size_t WS_ACT = WS_GU + al4k((size_t)NROW_MAX * 2 * DFF * 2);
constexpr size_t WS_Y = WS_ACT + al4k((size_t)NROW_MAX * DFF * 2);
constexpr size_t WS_END = WS_Y + al4k((size_t)NROW_MAX * D * 2);

struct P { const float* in[19]; float* out; unsigned char* ws; };

__device__ __forceinline__ unsigned f2bf(float f) { unsigned u = __builtin_bit_cast(unsigned, f); return (u + 0x7fffu + ((u >> 16) & 1u)) >> 16; }
__device__ __forceinline__ unsigned pk2(float lo, float hi) { unsigned r; asm("v_cvt_pk_bf16_f32 %0, %1, %2" : "=v"(r) : "v"(lo), "v"(hi)); return r; }
__device__ __forceinline__ float bf2f(unsigned short b) { return __builtin_bit_cast(float, (unsigned)b << 16); }
__device__ __forceinline__ float bflo(unsigned w) { return __builtin_bit_cast(float, w << 16); }
__device__ __forceinline__ float bfhi(unsigned w) { return __builtin_bit_cast(float, w & 0xffff0000u); }
__device__ __forceinline__ float wave_sum(float v) {
    v += pg8::xshfl<1>(v); v += pg8::xshfl<2>(v); v += pg8::xshfl<4>(v); v += pg8::xshfl<8>(v); v += pg8::xshfl<16>(v); v += pg8::xshfl<32>(v);
    return v;
}
__device__ __forceinline__ float gelu_erf(float x) { return 0.5f * x * (1.0f + erff(x * 0.70710678118654752f)); }
__device__ __forceinline__ float sigmoidf_(float x) { return 1.0f / (1.0f + __expf(-x)); }

__device__ __forceinline__ int lane_now() { int l; asm volatile("v_mbcnt_lo_u32_b32 %0, -1, 0\n\tv_mbcnt_hi_u32_b32 %0, -1, %0" : "=v"(l)); return l; }
#define XB_TMO      128
#define XB_XCNT(j)  (256  + 64 * (j))
#define XB_XSUB(j)  (1280 + 64 * (j))
#define XB_XGEN(j)  (2304 + 64 * (j))
#define XB_TOP      3328
#define XB_TOPGEN   3392
#define XCD_BAR_WORDS 3456
#define XB_SPIN_CAP (1u << 18)

__device__ __forceinline__ unsigned xb_ld(unsigned* p)              { return __hip_atomic_load(p, __ATOMIC_RELAXED, __HIP_MEMORY_SCOPE_AGENT); }
__device__ __forceinline__ unsigned xb_add(unsigned* p, unsigned v) { return __hip_atomic_fetch_add(p, v, __ATOMIC_RELAXED, __HIP_MEMORY_SCOPE_AGENT); }
__device__ __forceinline__ unsigned xb_xcc_id() { return (unsigned)__builtin_amdgcn_s_getreg((3 << 11) | 20) & 0xFu; }
#define XB_SPIN(cond, bar) do { unsigned _sp = 0; while (cond) { __builtin_amdgcn_s_sleep(1); \
    if ((++_sp & 255u) == 0u) { if (xb_ld(&(bar)[XB_TMO])) break; if (_sp > XB_SPIN_CAP) { atomicAdd(&(bar)[XB_TMO], 1u); break; } } } } while (0)

struct XcdBarrier {
    unsigned* bar; unsigned x;
    volatile LAS unsigned* st;
};

__device__ __forceinline__ XcdBarrier xcd_barrier_post(unsigned* bar, volatile LAS unsigned* st) {
    XcdBarrier b; b.bar = bar; b.x = xb_xcc_id(); b.st = st;
    if (threadIdx.x == 0) (void)xb_add(&bar[XB_XCNT(b.x)], 1u);
    return b;
}
__device__ __forceinline__ void xcd_barrier_complete(unsigned* bar, unsigned x, unsigned& nloc, unsigned& nx) {
    const unsigned G = gridDim.x * gridDim.y * gridDim.z;
    unsigned sum, cnt, mine, sp = 0u;
    for (;;) {
        sum = 0u; cnt = 0u; mine = 0u;
#pragma unroll
        for (unsigned j = 0; j < 16; ++j) { const unsigned c = xb_ld(&bar[XB_XCNT(j)]); sum += c; cnt += (c > 0u) ? 1u : 0u; mine = (j == x) ? c : mine; }
        if (sum == G) break;
        __builtin_amdgcn_s_sleep(1);
        if ((++sp & 255u) == 0u) { if (xb_ld(&bar[XB_TMO])) break; if (sp > XB_SPIN_CAP) { atomicAdd(&bar[XB_TMO], 1u); break; } }
    }
    nloc = mine > 0u ? mine : 1u; nx = cnt > 0u ? cnt : 1u;
}

__device__ __forceinline__ void xcd_barrier(const XcdBarrier& b, int wv) {
    asm volatile("s_waitcnt vmcnt(0)" ::: "memory");
    __syncthreads();
    if (wv == 0 && lane_now() == 0) {
        unsigned* bar = b.bar; asm volatile("" : "+s"(bar));
        __builtin_amdgcn_s_waitcnt(0);
        const unsigned bx = xb_xcc_id();
        unsigned nloc = b.st[0], nx = b.st[1];
        if (nloc == 0u) { xcd_barrier_complete(bar, bx, nloc, nx); b.st[0] = nloc; b.st[1] = nx; }
        const unsigned old = xb_add(&bar[XB_XSUB(bx)], 1u);
        const unsigned gen = old / nloc;
        if (old + 1u == (gen + 1u) * nloc) {
            __builtin_amdgcn_fence(__ATOMIC_RELEASE, "agent");
            asm volatile("s_waitcnt vmcnt(0)" ::: "memory");
            const unsigned og = xb_add(&bar[XB_TOP], 1u);
            const unsigned tg = og / nx;
            if (og + 1u == (tg + 1u) * nx) xb_add(&bar[XB_TOPGEN], 1u);
            else XB_SPIN(xb_ld(&bar[XB_TOPGEN]) == tg, bar);
            __builtin_amdgcn_fence(__ATOMIC_ACQUIRE, "agent");
            xb_add(&bar[XB_XGEN(bx)], 1u);
            asm volatile("s_waitcnt vmcnt(0)" ::: "memory");
        } else {
            XB_SPIN(xb_ld(&bar[XB_XGEN(bx)]) == gen, bar);
            __builtin_amdgcn_fence(__ATOMIC_ACQUIRE, "agent");
            asm volatile("s_waitcnt vmcnt(0)" ::: "memory");
        }
    }
    __syncthreads();
}


struct Ctx { int tid, lane, wave, gw, ngw; LAS unsigned char* lds; };
__device__ __forceinline__ Ctx make_ctx(LAS unsigned char* lds, int wv) { asm volatile("" : "+s"(wv)); int t = wv * 64 + lane_now(); asm volatile("" : "+v"(t));
    Ctx cx; cx.tid = t; cx.lane = t & 63; cx.wave = __builtin_amdgcn_readfirstlane(t >> 6); cx.gw = blockIdx.x * NWAVES + cx.wave; cx.ngw = gridDim.x * NWAVES; cx.lds = lds; return cx; }

template <int MODE>
__device__ __forceinline__ void transpose_item(const float* W, int K, int N, bf16* WT, LAS float* scr, int item, int lane) {
    const int nblk = N / 32, kb = item / nblk, nb = item % nblk, k0 = 64 * kb, n0 = 32 * nb;
    int d0 = n0;
    if (MODE == 1) d0 = ((n0 & 1023) >> 7) * 256 + (n0 >> 10) * 128 + (n0 & 127);
    if (MODE == 2) { const int s = n0 >> 10, c = n0 & 1023, t = c >> 7, o = c & 127;
        d0 = s == 0 ? t * 256 + o : s == 2 ? t * 256 + 128 + o : s == 1 ? (8 + t) * 256 + o : s == 5 ? (8 + t) * 256 + 128 + o : s == 3 ? (16 + t) * 256 + o : s == 6 ? (16 + t) * 256 + 128 + o : 24 * 256 + c; }
#pragma unroll 8
    for (int i = 0; i < 32; ++i) { const int kk = 2 * i + (lane >> 5); scr[kk * 33 + (lane & 31)] = W[(size_t)(k0 + kk) * N + n0 + (lane & 31)]; }
    asm volatile("s_waitcnt lgkmcnt(0)" ::: "memory");
    const int c = lane & 7;
#pragma unroll
    for (int j = 0; j < 4; ++j) { const int n = (lane >> 3) + 8 * j; const LAS float* s = scr + (8 * c) * 33 + n;
        if (MODE == 1 || MODE == 3) { u32x2 o; o.x = 0u; o.y = 0u;
            o.x = __builtin_amdgcn_cvt_pk_fp8_f32(s[0 * 33] * WSCALE, s[1 * 33] * WSCALE, o.x, false); o.x = __builtin_amdgcn_cvt_pk_fp8_f32(s[2 * 33] * WSCALE, s[3 * 33] * WSCALE, o.x, true);
            o.y = __builtin_amdgcn_cvt_pk_fp8_f32(s[4 * 33] * WSCALE, s[5 * 33] * WSCALE, o.y, false); o.y = __builtin_amdgcn_cvt_pk_fp8_f32(s[6 * 33] * WSCALE, s[7 * 33] * WSCALE, o.y, true);
            *(u32x2*)((unsigned char*)WT + (size_t)(d0 + n) * K + k0 + 8 * c) = o; }
        else { u32x4 o; o.x = pk2(s[0 * 33], s[1 * 33]); o.y = pk2(s[2 * 33], s[3 * 33]); o.z = pk2(s[4 * 33], s[5 * 33]); o.w = pk2(s[6 * 33], s[7 * 33]);
            *(u32x4*)(WT + (size_t)(d0 + n) * K + k0 + 8 * c) = o; } }
    asm volatile("s_waitcnt lgkmcnt(0)" ::: "memory");
}

__device__ __forceinline__ void win_block_item(const float* W, signed char* WQ, float* wsc, LAS unsigned char* lds, int item, int wave, int lane, int tid) {
    const int n0 = 32 * item, s = n0 >> 10, c = n0 & 1023, t = c >> 7, o = c & 127;
    const int d0 = s == 0 ? t * 256 + o : s == 2 ? t * 256 + 128 + o : s == 1 ? (8 + t) * 256 + o : s == 5 ? (8 + t) * 256 + 128 + o : s == 3 ? (16 + t) * 256 + o : s == 6 ? (16 + t) * 256 + 128 + o : 24 * 256 + c;
    LAS float* wmax = (LAS float*)(lds + 8 * 16384);
    LAS float* invs = wmax + 256;
    const int ng = lane & 7, kq = lane >> 3;
    f32x4 v[16]; f32x4 mx = (f32x4){0.f, 0.f, 0.f, 0.f};
    { const float* wp = W + (size_t)(128 * wave + 16 * kq) * DIN + n0 + 4 * ng;
#pragma unroll
      for (int i = 0; i < 16; ++i) v[i] = *(const f32x4*)(wp + (size_t)i * DIN);
#pragma unroll
      for (int i = 0; i < 16; ++i) { mx.x = fmaxf(mx.x, fabsf(v[i].x)); mx.y = fmaxf(mx.y, fabsf(v[i].y)); mx.z = fmaxf(mx.z, fabsf(v[i].z)); mx.w = fmaxf(mx.w, fabsf(v[i].w)); } }
#pragma unroll
    for (int c = 0; c < 4; ++c) { mx[c] = fmaxf(mx[c], pg8::xshfl<8>(mx[c])); mx[c] = fmaxf(mx[c], pg8::xshfl<16>(mx[c])); mx[c] = fmaxf(mx[c], pg8::xshfl<32>(mx[c])); }
    if (kq == 0) *(LAS f32x4*)(wmax + wave * 32 + 4 * ng) = mx;
    __syncthreads();
    if (tid < 32) { float m = wmax[tid];
#pragma unroll
        for (int w = 1; w < 8; ++w) m = fmaxf(m, wmax[w * 32 + tid]);
        invs[tid] = m > 0.f ? 127.0f / m : 0.f; wsc[d0 + tid] = m > 0.f ? m * (1.0f / 127.0f) : 1.0f; }
    __syncthreads();
    { const f32x4 iv = *(const LAS f32x4*)(invs + 4 * ng);
      signed char* dst = WQ + (size_t)(d0 + 4 * ng) * D + 128 * wave + 16 * kq;
#pragma unroll
      for (int c = 0; c < 4; ++c) { unsigned o[4];
#pragma unroll
          for (int t4 = 0; t4 < 4; ++t4) { const int q0 = (int)__builtin_rintf(v[4 * t4][c] * iv[c]) & 0xff, q1 = (int)__builtin_rintf(v[4 * t4 + 1][c] * iv[c]) & 0xff, q2 = (int)__builtin_rintf(v[4 * t4 + 2][c] * iv[c]) & 0xff, q3 = (int)__builtin_rintf(v[4 * t4 + 3][c] * iv[c]) & 0xff;
              o[t4] = (unsigned)q0 | ((unsigned)q1 << 8) | ((unsigned)q2 << 16) | ((unsigned)q3 << 24); }
          *(u32x4*)(dst + (size_t)c * D) = (u32x4){o[0], o[1], o[2], o[3]}; } }
    __syncthreads();
}

__device__ __forceinline__ void phase_prologue(const P& p, LAS unsigned char* lds_, int wv_) {
    const Ctx cx = make_ctx(lds_, wv_);
    const bool rev = (blockIdx.x & 1) != 0;
    for (int step = 0; step < 3; ++step) {
    const int part = rev ? 2 - step : step;
    if (part == 0) {
    {
        const float* c = p.in[1]; const float* w_ada = p.in[2]; const float* b_ada = p.in[3];
        float* mod = (float*)(p.ws + WS_MOD);
        LAS float* red = (LAS float*)cx.lds;
        LAS float* sl = (LAS float*)(cx.lds + 8192);
        if (blockIdx.x < NL * 48) { for (int i = cx.tid; i < 2 * D; i += NTHREADS) { const float cv = c[i]; sl[i] = cv / (1.0f + expf(-cv)); } }
        __syncthreads();
        const int h = cx.lane >> 5, li = cx.lane & 31;
        for (int item = blockIdx.x; item < NL * 48; item += gridDim.x) {
            const int l = item / 48, col0 = (item % 48) * 128;
            f32x4 a0 = (f32x4){0.f, 0.f, 0.f, 0.f}, a1 = a0;
            const float* wp = w_ada + ((size_t)l * D + cx.wave * 128) * 6144 + col0 + 4 * li;
#pragma unroll 32
            for (int i = 0; i < 64; ++i) {
                const int kk = 2 * i + h, k = cx.wave * 128 + kk;
                const float s0 = sl[k], s1 = sl[D + k];
                const f32x4 wv = *(const f32x4*)(wp + (size_t)kk * 6144);
                a0 += wv * s0; a1 += wv * s1;
            }
#pragma unroll
            for (int j = 0; j < 4; ++j) { a0[j] += pg8::xshfl<32>(a0[j]); a1[j] += pg8::xshfl<32>(a1[j]); }
            if (h == 0) { *(LAS f32x4*)(red + (cx.wave * 2 + 0) * 128 + 4 * li) = a0; *(LAS f32x4*)(red + (cx.wave * 2 + 1) * 128 + 4 * li) = a1; }
            __syncthreads();
            if (cx.tid < 256) { const int b = cx.tid >> 7, col = cx.tid & 127; float s = b_ada[l * 6144 + col0 + col];
#pragma unroll
                for (int w = 0; w < 8; ++w) s += red[(w * 2 + b) * 128 + col];
                mod[(size_t)(l * 2 + b) * 6144 + col0 + col] = s; }
            __syncthreads();
        }
    }
    {
        const float* rw = p.in[12]; bf16* RTH = (bf16*)(p.ws + WS_RTH); bf16* RTL = (bf16*)(p.ws + WS_RTL);
        for (int idx = blockIdx.x * NTHREADS + cx.tid; idx < NL * NE * D; idx += gridDim.x * NTHREADS) {
            const int l = idx / (NE * D), r = idx % (NE * D), e = r / D, k = r % D;
            const float w = rw[((size_t)l * D + k) * NE + e]; const unsigned hi = f2bf(w);
            RTH[idx] = (bf16)hi; RTL[idx] = (bf16)f2bf(w - __builtin_bit_cast(float, hi << 16));
        }
    }
    {
        const float* ws = p.in[7]; bf16* WSB = (bf16*)(p.ws + WS_WSB);
        for (int idx = blockIdx.x * NTHREADS + cx.tid; idx < NL * NG * CHK * CHK; idx += gridDim.x * NTHREADS) { const int s = idx & 127, t = (idx >> 7) & 127; WSB[idx] = (bf16)f2bf(s <= t ? ws[idx] : 0.f); }
    }
    }
    if (part == 1) {
    for (int item = blockIdx.x; item < NL * 224; item += gridDim.x) { const int mi = item / 224;
        win_block_item(p.in[5] + (size_t)mi * D * DIN, (signed char*)(p.ws + WS_WIN) + (size_t)mi * DIN * D, (float*)(p.ws + WS_WSC) + (size_t)mi * DIN, cx.lds, item % 224, cx.wave, cx.lane, cx.tid); }
    }
    if (part == 2) {
    {
        LAS float* scr = (LAS float*)(cx.lds + cx.wave * 16384);
        constexpr int I_GU = 16 * 64, I_DN = 16 * 32, I_IN = 224  , I_OUT = 16 * 32;
        const int N_GU = gridDim.x == 256 ? 0 : NL * NE * I_GU, N_DN = gridDim.x == 256 ? 0 : NL * NE * I_DN; constexpr int N_OUT = NL * I_OUT;
        const int NITEMS = N_GU + N_DN + N_OUT;
        for (int it = cx.gw; it < NITEMS; it += cx.ngw) {
            int r = it;
            if (r < N_GU) { const int mi = r / I_GU; transpose_item<1>(p.in[14] + (size_t)mi * D * 2 * DFF, D, 2 * DFF, (bf16*)(p.ws + WS_WGU + (size_t)mi * 2 * DFF * D), scr, r % I_GU, cx.lane); continue; } r -= N_GU;
            if (r < N_DN) { const int mi = r / I_DN; transpose_item<3>(p.in[16] + (size_t)mi * DFF * D, DFF, D, (bf16*)(p.ws + WS_WDN + (size_t)mi * D * DFF), scr, r % I_DN, cx.lane); continue; } r -= N_DN;
            { const int mi = r / I_OUT; transpose_item<0>(p.in[10] + (size_t)mi * D * D, D, D, (bf16*)(p.ws + WS_WOUT) + (size_t)mi * D * D, scr, r % I_OUT, cx.lane); }
        }
    }
    }
    __syncthreads();
    }
}

template <int MODE>
__device__ __forceinline__ void phase_norm1(const P& p, LAS unsigned char* lds_, int wv_, int l) {
    const Ctx cx = make_ctx(lds_, wv_);
    const float* mod = (const float*)(p.ws + WS_MOD);
    bf16* xres = (bf16*)(p.ws + WS_XRES);
    bf16* H = (bf16*)(p.ws + WS_H);
    const unsigned char* Y = p.ws + WS_Y;
    const int* arow = (const int*)(p.ws + WS_AROW); const float* aw = (const float*)(p.ws + WS_AW);
    LAS float* gL = (LAS float*)cx.lds;
    LAS float* shL = gL + D;
    LAS float* scL = shL + 2 * D;
    LAS float* gfL = scL + 2 * D;
    for (int i = cx.tid; i < D / 4; i += NTHREADS) {
        ((LAS f32x4*)gL)[i] = (MODE == 2) ? ((const f32x4*)p.in[18])[i] : ((const f32x4*)(p.in[4] + (size_t)l * D))[i];
#pragma unroll
        for (int b = 0; b < 2; ++b) {
            if (MODE != 2) { ((LAS f32x4*)(shL + b * D))[i] = ((const f32x4*)(mod + (size_t)(l * 2 + b) * 6144 + 0 * D))[i]; ((LAS f32x4*)(scL + b * D))[i] = ((const f32x4*)(mod + (size_t)(l * 2 + b) * 6144 + 1 * D))[i] + 1.0f; }
            if (MODE != 0) ((LAS f32x4*)(gfL + b * D))[i] = ((const f32x4*)(mod + (size_t)((l - 1) * 2 + b) * 6144 + 5 * D))[i];
        }
    }
    __syncthreads();
    const int step = 2 * cx.ngw;
    int arN[2][TOPK]; float awN[2][TOPK]; float awC[2][TOPK]; unsigned qC[2][TOPK][4]; u32x2 xC[2][4];
#define N1_IDX(ROW0_, AR_, AW_) do { _Pragma("unroll") for (int u_ = 0; u_ < 2; ++u_) _Pragma("unroll") for (int k_ = 0; k_ < TOPK; ++k_) { AR_[u_][k_] = arow[((ROW0_) + u_ * cx.ngw) * 4 + k_]; AW_[u_][k_] = aw[((ROW0_) + u_ * cx.ngw) * 4 + k_]; } } while (0)
#define N1_LOAD(ROW0_, AR_, Q_, X_) do { _Pragma("unroll") for (int u_ = 0; u_ < 2; ++u_) { const u32x2* xr_ = (const u32x2*)(xres + (size_t)((ROW0_) + u_ * cx.ngw) * D) + cx.lane; \
        _Pragma("unroll") for (int j_ = 0; j_ < 4; ++j_) X_[u_][j_] = xr_[64 * j_]; \
        _Pragma("unroll") for (int k_ = 0; k_ < TOPK; ++k_) { const unsigned* yr_ = (const unsigned*)(Y + (size_t)AR_[u_][k_] * D) + cx.lane; _Pragma("unroll") for (int j_ = 0; j_ < 4; ++j_) Q_[u_][k_][j_] = yr_[64 * j_]; } } } while (0)
    if (MODE != 0) { int ar0[2][TOPK]; N1_IDX(cx.gw, ar0, awC); N1_LOAD(cx.gw, ar0, qC, xC); if (cx.gw + step < T) N1_IDX(cx.gw + step, arN, awN); }
    for (int row0 = cx.gw; row0 < T; row0 += step) {
        f32x4 v[2][4]; int rr[2];
#pragma unroll
        for (int u = 0; u < 2; ++u) rr[u] = row0 + u * cx.ngw;
        if (MODE == 0) {
#pragma unroll
            for (int u = 0; u < 2; ++u) { const f32x4* xr = (const f32x4*)(p.in[0] + (size_t)rr[u] * D) + cx.lane;
#pragma unroll
                for (int j = 0; j < 4; ++j) v[u][j] = xr[64 * j]; }
        } else {
            unsigned qX[2][TOPK][4]; u32x2 xX[2][4]; int arX[2][TOPK]; float awX[2][TOPK];
            const bool h1 = row0 + step < T, h2 = row0 + 2 * step < T;
            if (h1) N1_LOAD(row0 + step, arN, qX, xX);
            if (h2) N1_IDX(row0 + 2 * step, arX, awX);
#pragma unroll
            for (int u = 0; u < 2; ++u) {
                const int b = rr[u] / SEQ;
                const LAS f32x4* gf = (const LAS f32x4*)(gfL + b * D) + cx.lane;
                u32x2* xw = (u32x2*)(xres + (size_t)rr[u] * D) + cx.lane;
#pragma unroll
                for (int j = 0; j < 4; ++j) { const u32x2 xq = xC[u][j]; v[u][j] = (f32x4){bflo(xq.x), bfhi(xq.x), bflo(xq.y), bfhi(xq.y)};
                    f32x4 acc = (f32x4){0.f, 0.f, 0.f, 0.f};
#pragma unroll
                    for (int k = 0; k < TOPK; ++k) { const auto lo = __builtin_amdgcn_cvt_pk_f32_fp8(qC[u][k][j], false), hi = __builtin_amdgcn_cvt_pk_f32_fp8(qC[u][k][j], true); acc += (f32x4){lo[0], lo[1], hi[0], hi[1]} * (awC[u][k] * (1.0f / YSCALE)); }
                    v[u][j] += gf[64 * j] * acc; if (MODE == 1) { u32x2 w; w.x = pk2(v[u][j].x, v[u][j].y); w.y = pk2(v[u][j].z, v[u][j].w); xw[64 * j] = w; } }
            }
#pragma unroll
            for (int u = 0; u < 2; ++u) {
#pragma unroll
                for (int k = 0; k < TOPK; ++k) { awC[u][k] = awN[u][k]; if (h2) { awN[u][k] = awX[u][k]; arN[u][k] = arX[u][k]; }
#pragma unroll
                    for (int j = 0; j < 4; ++j) if (h1) qC[u][k][j] = qX[u][k][j]; }
#pragma unroll
                for (int j = 0; j < 4; ++j) if (h1) xC[u][j] = xX[u][j]; }
        }
#pragma unroll
        for (int u = 0; u < 2; ++u) {
            const int row = rr[u], b = row / SEQ;
            float ss = 0.f;
#pragma unroll
            for (int j = 0; j < 4; ++j) ss += (v[u][j].x * v[u][j].x + v[u][j].y * v[u][j].y) + (v[u][j].z * v[u][j].z + v[u][j].w * v[u][j].w);
            const float rstd = 1.0f / sqrtf(wave_sum(ss) * (1.0f / D) + EPS);
            const LAS f32x4* g = (const LAS f32x4*)gL + cx.lane;
            if (MODE == 2) {
                f32x4* o = (f32x4*)(p.out + (size_t)row * D) + cx.lane;
#pragma unroll
                for (int j = 0; j < 4; ++j) o[64 * j] = v[u][j] * rstd * g[64 * j];
            } else {
                const LAS f32x4* sh = (const LAS f32x4*)(shL + b * D) + cx.lane;
                const LAS f32x4* sc = (const LAS f32x4*)(scL + b * D) + cx.lane;
                f32x4 hh[4]; float am = 0.f;
#pragma unroll
                for (int j = 0; j < 4; ++j) { hh[j] = v[u][j] * rstd * g[64 * j] * sc[64 * j] + sh[64 * j]; am = fmaxf(fmaxf(am, fmaxf(fabsf(hh[j].x), fabsf(hh[j].y))), fmaxf(fabsf(hh[j].z), fabsf(hh[j].w))); }
                am = fmaxf(am, pg8::xshfl<1>(am)); am = fmaxf(am, pg8::xshfl<2>(am)); am = fmaxf(am, pg8::xshfl<4>(am)); am = fmaxf(am, pg8::xshfl<8>(am)); am = fmaxf(am, pg8::xshfl<16>(am)); am = fmaxf(am, pg8::xshfl<32>(am));
                const float inv = am > 0.f ? 127.0f / am : 0.f;
                unsigned* o = (unsigned*)((signed char*)H + (size_t)row * D) + cx.lane;
#pragma unroll
                for (int j = 0; j < 4; ++j) { const int q0 = (int)__builtin_rintf(hh[j].x * inv) & 0xff, q1 = (int)__builtin_rintf(hh[j].y * inv) & 0xff, q2 = (int)__builtin_rintf(hh[j].z * inv) & 0xff, q3 = (int)__builtin_rintf(hh[j].w * inv) & 0xff;
                    o[64 * j] = (unsigned)q0 | ((unsigned)q1 << 8) | ((unsigned)q2 << 16) | ((unsigned)q3 << 24); }
                if (cx.lane == 0) ((float*)(p.ws + WS_HS))[row] = am > 0.f ? am * (1.0f / 127.0f) : 1.0f;
            }
        }
    }
}

#undef N1_IDX
#undef N1_LOAD
typedef short bf16x8_m __attribute__((ext_vector_type(8)));
__device__ __forceinline__ void unpack8(const u32x4 w, float (&f)[8]) {
#pragma unroll
    for (int j = 0; j < 4; ++j) { f[2 * j] = bflo(w[j]); f[2 * j + 1] = bfhi(w[j]); } }
__device__ __forceinline__ void phase_mixer(const P& p, LAS unsigned char* lds_, int wv_, int l) {
    const Ctx cx = make_ctx(lds_, wv_);
    const bf16* PB = (const bf16*)(p.ws + WS_Z); const bf16* QA = PB + (size_t)T * D; const bf16* GU = QA + (size_t)T * D; const bf16* GV = GU + (size_t)T * D;
    bf16* MB = (bf16*)(p.ws + WS_M);
    const float* vst = (const float*)(p.ws + WS_VST);
    const bf16* WSB = (const bf16*)(p.ws + WS_WSB) + (size_t)l * NG * CHK * CHK;
    const float* conv_w = p.in[6] + (size_t)l * 3 * D; const float* b_s = p.in[8] + (size_t)l * NG * CHK; const float* ln_g = p.in[9] + (size_t)l * D;
    constexpr int RS = 272;
    LAS unsigned char* WmL = cx.lds;
    LAS unsigned char* VT = cx.lds + 128 * RS;
    LAS float* SL = (LAS float*)(cx.lds + 2 * 128 * RS);
    LAS float* st = (LAS float*)(cx.lds + 2 * 128 * RS + 128 * 132 * 4);
    LAS float* lngL = st + 256;
    LAS float* cwL = lngL + D;
    LAS float* bsL = cwL + 3 * D;
    for (int i = cx.tid; i < D / 4; i += NTHREADS) { ((LAS f32x4*)lngL)[i] = ((const f32x4*)ln_g)[i]; ((LAS f32x4*)bsL)[i] = ((const f32x4*)b_s)[i]; }
    for (int i = cx.tid; i < 3 * D / 4; i += NTHREADS) ((LAS f32x4*)cwL)[i] = ((const f32x4*)conv_w)[i];
    for (int chunk = blockIdx.x; chunk < NCHUNK; chunk += gridDim.x) {
        const int tok0 = chunk * CHK;
        if (cx.tid < CHK) { const f32x4* sp = (const f32x4*)(vst + (size_t)(tok0 + cx.tid) * 32); float s = 0.f, q = 0.f;
#pragma unroll
            for (int j = 0; j < 8; ++j) { const f32x4 t4 = sp[j]; s += t4.x + t4.z; q += t4.y + t4.w; }
            const float mean = s * (1.0f / D), var = fmaxf(q * (1.0f / D) - mean * mean, 0.f);
            st[cx.tid] = mean; st[128 + cx.tid] = 1.0f / sqrtf(var + EPS); }
        __syncthreads();
        u32x4 wq[4], vq[4];
#pragma unroll
        for (int i = 0; i < 4; ++i) { const int idx = cx.tid + NTHREADS * i; wq[i] = *(const u32x4*)(WSB + idx * 8);
            const int s = idx & 127, c8 = idx >> 7; vq[i] = *(const u32x4*)(GV + (size_t)(tok0 + s) * D + c8 * 8); }
#define MIX_LOAD(G_, I_) do { const int idx_ = cx.tid + NTHREADS * (I_), t_ = idx_ >> 4, c8_ = idx_ & 15, tok_ = tok0 + t_, tseq_ = tok_ & (SEQ - 1); const size_t off_ = (size_t)tok_ * D + (G_) * CHK + c8_ * 8; \
            eg[I_] = *(const u32x4*)(GU + off_); eq[I_] = *(const u32x4*)(QA + off_); e0[I_] = *(const u32x4*)(PB + off_); \
            e1[I_] = tseq_ >= 1 ? *(const u32x4*)(PB + off_ - D) : (u32x4){0u, 0u, 0u, 0u}; e2[I_] = tseq_ >= 2 ? *(const u32x4*)(PB + off_ - 2 * D) : (u32x4){0u, 0u, 0u, 0u}; } while (0)
        u32x4 eg[4], eq[4], e0[4], e1[4], e2[4];
#pragma unroll
        for (int i = 0; i < 4; ++i) MIX_LOAD(0, i);
        for (int g = 0; g < NG; ++g) {
#pragma unroll
            for (int i = 0; i < 4; ++i) { const int idx = cx.tid + NTHREADS * i; *(LAS u32x4*)(WmL + (idx >> 4) * RS + (idx & 15) * 16) = wq[i]; }
#pragma unroll
            for (int i = 0; i < 4; ++i) { const int idx = cx.tid + NTHREADS * i, s = idx & 127, c8 = idx >> 7; float f[8]; unpack8(vq[i], f);
                const float mu = st[s], rs = st[128 + s]; const f32x4 l0 = *(const LAS f32x4*)(lngL + g * CHK + c8 * 8), l1 = *(const LAS f32x4*)(lngL + g * CHK + c8 * 8 + 4);
                const float lg[8] = {l0.x, l0.y, l0.z, l0.w, l1.x, l1.y, l1.z, l1.w};
#pragma unroll
                for (int j = 0; j < 8; j += 2) { const unsigned w2 = pk2((f[j] - mu) * rs * lg[j], (f[j + 1] - mu) * rs * lg[j + 1]);
                    *(LAS unsigned short*)(VT + (c8 * 8 + j) * RS + s * 2) = (unsigned short)(w2 & 0xffffu); *(LAS unsigned short*)(VT + (c8 * 8 + j + 1) * RS + s * 2) = (unsigned short)(w2 >> 16); } }
            if (g + 1 < NG) {
#pragma unroll
                for (int i = 0; i < 4; ++i) { const int idx = cx.tid + NTHREADS * i; wq[i] = *(const u32x4*)(WSB + (size_t)(g + 1) * CHK * CHK + idx * 8);
                    const int s = idx & 127, c8 = idx >> 7; vq[i] = *(const u32x4*)(GV + (size_t)(tok0 + s) * D + (g + 1) * CHK + c8 * 8); }
            }
            __syncthreads();
            { const int fr = cx.lane & 15, fq = cx.lane >> 4, pp = cx.wave >> 1, hh = cx.wave & 1;
#pragma unroll
              for (int rbi = 0; rbi < 2; ++rbi) { const int rb = rbi ? 7 - pp : pp, nks = (rb >> 1) + 1; f32x4 acc[4];
#pragma unroll
                for (int nt = 0; nt < 4; ++nt) acc[nt] = (f32x4){0.f, 0.f, 0.f, 0.f};
                for (int ks = 0; ks < nks; ++ks) {
                    const bf16x8_m A = *(const LAS bf16x8_m*)(WmL + (rb * 16 + fr) * RS + (32 * ks + 8 * fq) * 2);
#pragma unroll
                    for (int nt = 0; nt < 4; ++nt) { const bf16x8_m B = *(const LAS bf16x8_m*)(VT + ((4 * hh + nt) * 16 + fr) * RS + (32 * ks + 8 * fq) * 2); acc[nt] = __builtin_amdgcn_mfma_f32_16x16x32_bf16(A, B, acc[nt], 0, 0, 0); }
                }
#pragma unroll
                for (int nt = 0; nt < 4; ++nt)
#pragma unroll
                    for (int r = 0; r < 4; ++r) SL[(rb * 16 + 4 * fq + r) * 132 + (4 * hh + nt) * 16 + fr] = acc[nt][r];
              }
            }
            __syncthreads();
#pragma unroll
            for (int i = 0; i < 4; ++i) { const int idx = cx.tid + NTHREADS * i, t = idx >> 4, c8 = idx & 15, tok = tok0 + t, ch0 = g * CHK + c8 * 8;
                const f32x4 s0 = *(const LAS f32x4*)(SL + t * 132 + c8 * 8), s1 = *(const LAS f32x4*)(SL + t * 132 + c8 * 8 + 4); const float sv[8] = {s0.x, s0.y, s0.z, s0.w, s1.x, s1.y, s1.z, s1.w};
                const float bs = bsL[g * CHK + t];
                float fg[8], fqa[8], f0[8], f1[8], f2[8]; unpack8(eg[i], fg); unpack8(eq[i], fqa); unpack8(e0[i], f0); unpack8(e1[i], f1); unpack8(e2[i], f2);
                float c0[8], c1[8], c2[8];
#pragma unroll
                for (int h = 0; h < 2; ++h) { const f32x4 a = *(const LAS f32x4*)(cwL + ch0 + 4 * h), bq = *(const LAS f32x4*)(cwL + D + ch0 + 4 * h), c = *(const LAS f32x4*)(cwL + 2 * D + ch0 + 4 * h);
#pragma unroll
                    for (int j = 0; j < 4; ++j) { c0[4 * h + j] = a[j]; c1[4 * h + j] = bq[j]; c2[4 * h + j] = c[j]; } }
                float o[8];
#pragma unroll
                for (int j = 0; j < 8; ++j) o[j] = fqa[j] * (c0[j] * f2[j] + c1[j] * f1[j] + c2[j] * f0[j]) + fg[j] * (sv[j] + bs);
                u32x4 w; w.x = pk2(o[0], o[1]); w.y = pk2(o[2], o[3]); w.z = pk2(o[4], o[5]); w.w = pk2(o[6], o[7]);
                *(u32x4*)(MB + (size_t)tok * D + ch0) = w;
                if (g + 1 < NG) MIX_LOAD(g + 1, i); }
        }
#undef MIX_LOAD
        __syncthreads();
    }
}

constexpr int CW_BAR = 4096;
constexpr int CW_RS = 16384;
typedef short bf16x8_t __attribute__((ext_vector_type(8)));
constexpr int RT_STRIDE = 2064;
__device__ __forceinline__ void phase_router(const P& p, LAS unsigned char* lds_, int wv_, int l) {
    const Ctx cx = make_ctx(lds_, wv_);
    const float* mod = (const float*)(p.ws + WS_MOD); const bf16* xres = (const bf16*)(p.ws + WS_XRES); unsigned char* H8 = p.ws + WS_H8;
    const bf16* RTH = (const bf16*)(p.ws + WS_RTH) + (size_t)l * NE * D; const bf16* RTL = (const bf16*)(p.ws + WS_RTL) + (size_t)l * NE * D; const float* rb = p.in[13] + l * NE;
    const float* ssq = (const float*)(p.ws + WS_SSQ);
    int* cnt = (int*)(p.ws + WS_CNT); int* ae = (int*)(p.ws + WS_AE); int* ar = (int*)(p.ws + WS_AR); float* aw = (float*)(p.ws + WS_AW);
    LAS unsigned char* RH = cx.lds; LAS unsigned char* RL = cx.lds + 66048;
    LAS float* gsl = (LAS float*)(cx.lds + 132096); LAS float* shl = gsl + D;
    LAS int* wcnt = (LAS int*)(cx.lds + 140288);
    LAS int* wbase = wcnt + 256;
    LAS int* la_e = wbase + 256;
    LAS int* la_r = la_e + 512;
    const bool fused = gridDim.x == NCHUNK;
    for (int chunk = blockIdx.x; chunk < NCHUNK; chunk += gridDim.x) {
        const int b = (chunk * CHK) / SEQ;
        const int fr = cx.lane & 15, q = cx.lane >> 4, row = chunk * CHK + cx.wave * 16 + fr;
        const bf16* xr = xres + (size_t)row * D + 8 * q; unsigned char* hr = H8 + (size_t)row * D + 8 * q;
        f32x4 sq4[4];
        { const f32x4* sp = (const f32x4*)(ssq + (size_t)row * 16); sq4[0] = sp[0]; sq4[1] = sp[1]; sq4[2] = sp[2]; sq4[3] = sp[3]; }
        u32x4 xall[D / 32];
#pragma unroll
        for (int ks = 0; ks < D / 32; ++ks) xall[ks] = *(const u32x4*)(xr + 32 * ks);
        for (int idx = cx.tid; idx < NE * (D / 8); idx += NTHREADS) { const int e = idx >> 7, c8 = (idx & 127) * 8;
            *(LAS u32x4*)(RH + e * RT_STRIDE + c8 * 2) = *(const u32x4*)(RTH + (size_t)e * D + c8); *(LAS u32x4*)(RL + e * RT_STRIDE + c8 * 2) = *(const u32x4*)(RTL + (size_t)e * D + c8); }
        if (cx.tid < D / 4) { const f32x4 g = *((const f32x4*)(p.in[11] + (size_t)l * D) + cx.tid), sc = *((const f32x4*)(mod + (size_t)(l * 2 + b) * 6144 + 4 * D) + cx.tid), sh = *((const f32x4*)(mod + (size_t)(l * 2 + b) * 6144 + 3 * D) + cx.tid);
            *((LAS f32x4*)gsl + cx.tid) = g * (sc + 1.0f); *((LAS f32x4*)shl + cx.tid) = sh; }
        __syncthreads();
        float rstd;
        { const f32x4 s0 = sq4[0], s1 = sq4[1], s2 = sq4[2], s3 = sq4[3];
          const float s = ((s0.x + s0.y) + (s0.z + s0.w)) + ((s1.x + s1.y) + (s1.z + s1.w)) + ((s2.x + s2.y) + (s2.z + s2.w)) + ((s3.x + s3.y) + (s3.z + s3.w));
          rstd = 1.0f / sqrtf(s * (1.0f / D) + EPS); }
        f32x4 acc0 = (f32x4){0.f, 0.f, 0.f, 0.f}, acc1 = acc0;
#pragma unroll
        for (int ks = 0; ks < D / 32; ++ks) {
            const u32x4 xq = xall[ks]; const f32x4 x0 = (f32x4){bflo(xq.x), bfhi(xq.x), bflo(xq.y), bfhi(xq.y)}, x1 = (f32x4){bflo(xq.z), bfhi(xq.z), bflo(xq.w), bfhi(xq.w)};
            const f32x4 g0 = *(const LAS f32x4*)(gsl + 32 * ks + 8 * q), g1 = *(const LAS f32x4*)(gsl + 32 * ks + 8 * q + 4), h0 = *(const LAS f32x4*)(shl + 32 * ks + 8 * q), h1 = *(const LAS f32x4*)(shl + 32 * ks + 8 * q + 4);
            const f32x4 a0 = x0 * rstd * g0 + h0, a1 = x1 * rstd * g1 + h1;
            u32x4 hi, lo; float f[8] = {a0.x, a0.y, a0.z, a0.w, a1.x, a1.y, a1.z, a1.w};
#pragma unroll
            for (int j = 0; j < 4; ++j) { const unsigned hw = pk2(f[2 * j], f[2 * j + 1]); hi[j] = hw;
                lo[j] = pk2(f[2 * j] - __builtin_bit_cast(float, hw << 16), f[2 * j + 1] - __builtin_bit_cast(float, hw & 0xffff0000u)); }
            { u32x2 h8; h8.x = 0u; h8.y = 0u; h8.x = __builtin_amdgcn_cvt_pk_fp8_f32(f[0], f[1], h8.x, false); h8.x = __builtin_amdgcn_cvt_pk_fp8_f32(f[2], f[3], h8.x, true);
              h8.y = __builtin_amdgcn_cvt_pk_fp8_f32(f[4], f[5], h8.y, false); h8.y = __builtin_amdgcn_cvt_pk_fp8_f32(f[6], f[7], h8.y, true); *(u32x2*)(hr + 32 * ks) = h8; }
            const bf16x8_t Ah = __builtin_bit_cast(bf16x8_t, hi), Al = __builtin_bit_cast(bf16x8_t, lo);
            const int bo = fr * RT_STRIDE + (32 * ks + 8 * q) * 2;
            const bf16x8_t Bh0 = *(const LAS bf16x8_t*)(RH + bo), Bh1 = *(const LAS bf16x8_t*)(RH + 16 * RT_STRIDE + bo), Bl0 = *(const LAS bf16x8_t*)(RL + bo), Bl1 = *(const LAS bf16x8_t*)(RL + 16 * RT_STRIDE + bo);
            acc0 = __builtin_amdgcn_mfma_f32_16x16x32_bf16(Ah, Bh0, acc0, 0, 0, 0); acc1 = __builtin_amdgcn_mfma_f32_16x16x32_bf16(Ah, Bh1, acc1, 0, 0, 0);
            acc0 = __builtin_amdgcn_mfma_f32_16x16x32_bf16(Ah, Bl0, acc0, 0, 0, 0); acc1 = __builtin_amdgcn_mfma_f32_16x16x32_bf16(Ah, Bl1, acc1, 0, 0, 0);
            acc0 = __builtin_amdgcn_mfma_f32_16x16x32_bf16(Al, Bh0, acc0, 0, 0, 0); acc1 = __builtin_amdgcn_mfma_f32_16x16x32_bf16(Al, Bh1, acc1, 0, 0, 0);
        }
        __syncthreads();
        LAS float* lgw = (LAS float*)(cx.lds + cx.wave * 2048);
        { const float b0 = rb[fr], b1 = rb[16 + fr];
#pragma unroll
          for (int r = 0; r < 4; ++r) { lgw[(4 * q + r) * 32 + fr] = acc0[r] + b0; lgw[(4 * q + r) * 32 + 16 + fr] = acc1[r] + b1; } }
        asm volatile("s_waitcnt lgkmcnt(0)" ::: "memory");
        if (cx.lane < 16) {
            float lg[NE];
#pragma unroll
            for (int j = 0; j < 8; ++j) { const f32x4 t4 = *(const LAS f32x4*)(lgw + cx.lane * 32 + 4 * j); lg[4 * j] = t4.x; lg[4 * j + 1] = t4.y; lg[4 * j + 2] = t4.z; lg[4 * j + 3] = t4.w; }
            int sel[TOPK]; float sv[TOPK]; unsigned taken = 0u;
#pragma unroll
            for (int k = 0; k < TOPK; ++k) { float best = -3.0e38f; int bi = 0;
#pragma unroll
                for (int e = 0; e < NE; ++e) { const bool ok = !((taken >> e) & 1u) && (lg[e] > best); best = ok ? lg[e] : best; bi = ok ? e : bi; }
                sel[k] = bi; sv[k] = best; taken |= 1u << bi; }
            float ex[TOPK], den = 0.f;
#pragma unroll
            for (int k = 0; k < TOPK; ++k) { ex[k] = expf(sv[k] - sv[0]); den += ex[k]; }
            const float inv = 1.0f / den; const int tok = chunk * CHK + cx.wave * 16 + cx.lane;
            *(f32x4*)(aw + (size_t)tok * 4) = (f32x4){ex[0] * inv, ex[1] * inv, ex[2] * inv, ex[3] * inv};
#pragma unroll
            for (int k = 0; k < TOPK; ++k) la_e[cx.wave * 64 + cx.lane * 4 + k] = sel[k];
        }
        asm volatile("s_waitcnt lgkmcnt(0)" ::: "memory");
        {
            const int ea = la_e[cx.wave * 64 + cx.lane]; int rk = 0, ce = 0;
            const unsigned long long below = (1ull << cx.lane) - 1ull;
#pragma unroll 8
            for (int e = 0; e < NE; ++e) { const unsigned long long m = __ballot(ea == e); if (ea == e) rk = __builtin_popcountll(m & below); if (cx.lane == e) ce = __builtin_popcountll(m); }
            la_r[cx.wave * 64 + cx.lane] = rk; if (cx.lane < NE) wcnt[cx.wave * NE + cx.lane] = ce;
        }
        __syncthreads();
        if (cx.tid < NE) { int tot = 0;
#pragma unroll
            for (int w = 0; w < NWAVES; ++w) { wbase[w * NE + cx.tid] = tot; tot += wcnt[w * NE + cx.tid]; }
            if (fused) __hip_atomic_store(&cnt[chunk * NE + cx.tid], tot, __ATOMIC_RELAXED, __HIP_MEMORY_SCOPE_AGENT); else cnt[chunk * NE + cx.tid] = tot; }
        __syncthreads();
        const int e_a = la_e[cx.wave * 64 + cx.lane], r_a = la_r[cx.wave * 64 + cx.lane] + wbase[cx.wave * NE + e_a];
        const int a = (chunk * CHK + cx.wave * 16) * 4 + cx.lane;
        if (!fused) { ae[a] = e_a; ar[a] = r_a; __syncthreads(); continue; }
        asm volatile("s_waitcnt vmcnt(0)" ::: "memory");
        if (cx.tid == 0) { unsigned* bar = (unsigned*)(p.ws + WS_CTL) + CW_BAR; unsigned* ctr = (unsigned*)(p.ws + WS_CTL) + CW_RS + 64 * l; asm volatile("" : "+s"(bar), "+s"(ctr));
            (void)xb_add(ctr, 1u); XB_SPIN(xb_ld(ctr) < (unsigned)NCHUNK, bar); }
        __syncthreads();
        {
            int t2 = cx.wave * 64 + lane_now(); asm volatile("" : "+v"(t2));
            int* arow = (int*)(p.ws + WS_AROW); int* rowtok = (int*)(p.ws + WS_ROWTOK); int* tab = (int*)(p.ws + WS_TAB);
            LAS int* s_tot = (LAS int*)(cx.lds + 32768); LAS int* s_before = s_tot + 32; LAS int* s_pstart = s_tot + 64; LAS int* s_base = s_tot + 96;
            LAS int* part_t = s_tot + 128; LAS int* part_b = part_t + 512;
            { const int e = t2 & 31, pt = t2 >> 5; int tot = 0, bef = 0;
#pragma unroll
              for (int i = 0; i < 16; ++i) { const int c2 = pt * 16 + i; const int v = __hip_atomic_load(&cnt[c2 * NE + e], __ATOMIC_RELAXED, __HIP_MEMORY_SCOPE_AGENT); tot += v; bef += (c2 < chunk) ? v : 0; }
              part_t[pt * 32 + e] = tot; part_b[pt * 32 + e] = bef; }
            __syncthreads();
            if (t2 < NE) { int total = 0, before = 0;
#pragma unroll
                for (int i = 0; i < 16; ++i) { total += part_t[i * 32 + t2]; before += part_b[i * 32 + t2]; }
                s_tot[t2] = total; s_before[t2] = before; }
            __syncthreads();
            if (t2 < NE) { int ps = 0;
#pragma unroll
                for (int e2 = 0; e2 < NE; ++e2) { const int v = (s_tot[e2] + 255) & ~255; ps += (e2 < t2) ? v : 0; }
                s_pstart[t2] = ps; s_base[t2] = ps + s_before[t2]; }
            __syncthreads();
            { const int dest = s_base[e_a] + r_a; rowtok[dest] = a >> 2; arow[a] = dest; }
            if (chunk < NE) { const int e = chunk, lo = s_pstart[e] + s_tot[e], hi = s_pstart[e] + ((s_tot[e] + 255) & ~255); for (int i = lo + t2; i < hi; i += NTHREADS) rowtok[i] = 0; }
            { const int i = (int)blockIdx.x + (int)gridDim.x * t2;
              if (i < NTILE_MAX) { int ee = 0;
#pragma unroll
                  for (int e = 0; e < NE; ++e) if (s_tot[e] > 0 && s_pstart[e] <= i * 256) ee = e;
                  tab[64 + i] = ee; }
              if (chunk == 0 && t2 == 0) tab[0] = (s_pstart[NE - 1] + ((s_tot[NE - 1] + 255) & ~255)) >> 8; }
        }
        __syncthreads();
    }
}

__device__ __forceinline__ void phase_scatter(const P& p, LAS unsigned char* lds_, int wv_) {
    const Ctx cx = make_ctx(lds_, wv_);
    const int* cnt = (const int*)(p.ws + WS_CNT); const int* ae = (const int*)(p.ws + WS_AE); const int* ar = (const int*)(p.ws + WS_AR);
    int* arow = (int*)(p.ws + WS_AROW); int* rowtok = (int*)(p.ws + WS_ROWTOK); int* tab = (int*)(p.ws + WS_TAB);
    LAS int* s_tot = (LAS int*)cx.lds; LAS int* s_before = s_tot + 32; LAS int* s_pstart = s_tot + 64; LAS int* s_base = s_tot + 96;
    LAS int* part_t = s_tot + 128; LAS int* part_b = part_t + 512;
    for (int chunk = blockIdx.x; chunk < NCHUNK; chunk += gridDim.x) {
        const int a = chunk * (CHK * TOPK) + cx.tid; const int ea = ae[a], ra = ar[a];
        { const int e = cx.tid & 31, pt = cx.tid >> 5; int tot = 0, bef = 0;
#pragma unroll
          for (int i = 0; i < 16; ++i) { const int c2 = pt * 16 + i; const int v = cnt[c2 * NE + e]; tot += v; bef += (c2 < chunk) ? v : 0; }
          part_t[pt * 32 + e] = tot; part_b[pt * 32 + e] = bef; }
        __syncthreads();
        if (cx.tid < NE) { int total = 0, before = 0;
#pragma unroll
            for (int i = 0; i < 16; ++i) { total += part_t[i * 32 + cx.tid]; before += part_b[i * 32 + cx.tid]; }
            s_tot[cx.tid] = total; s_before[cx.tid] = before; }
        __syncthreads();
        if (cx.tid < NE) { int ps = 0;
#pragma unroll
            for (int e2 = 0; e2 < NE; ++e2) { const int v = (s_tot[e2] + 255) & ~255; ps += (e2 < cx.tid) ? v : 0; }
            s_pstart[cx.tid] = ps; s_base[cx.tid] = ps + s_before[cx.tid]; }
        __syncthreads();
        { const int dest = s_base[ea] + ra; rowtok[dest] = a >> 2; arow[a] = dest; }
        if (chunk < NE) { const int e = chunk, lo = s_pstart[e] + s_tot[e], hi = s_pstart[e] + ((s_tot[e] + 255) & ~255); for (int i = lo + cx.tid; i < hi; i += NTHREADS) rowtok[i] = 0; }
        if (chunk == (int)blockIdx.x) {
            const int i = (int)blockIdx.x + (int)gridDim.x * cx.tid;
            if (i < NTILE_MAX) { int ee = 0;
#pragma unroll
                for (int e = 0; e < NE; ++e) if (s_tot[e] > 0 && s_pstart[e] <= i * 256) ee = e;
                tab[64 + i] = ee; }
            if (chunk == 0 && cx.tid == 0) tab[0] = (s_pstart[NE - 1] + ((s_tot[NE - 1] + 255) & ~255)) >> 8;
        }
        __syncthreads();
    }
}

__device__ __forceinline__ void phase_inproj(const P& p, LAS unsigned char* lds_, int wv_, int l) {
    pg8::Gemm g{(const bf16*)(p.ws + WS_H), (const bf16*)(p.ws + WS_WIN + (size_t)l * DIN * D), D, 0, 0};
    pg8::InprojOrder S; S.init(T, DIN, gridDim.x, blockIdx.x); S.gw0 = (int)blockIdx.x * NWAVES; S.njobs = gridDim.x == 256 ? 1 : 0; S.rot = gridDim.x == 256 ? (int)((blockIdx.x & 7u) % 7u) : 0;
    S.job = pg8::CvJob{p.in[14] + (size_t)l * NE * D * 2 * DFF, p.in[16] + (size_t)l * NE * DFF * D, p.ws + WS_WGU + (size_t)l * NE * 2 * DFF * D, p.ws + WS_WDN + (size_t)l * NE * D * DFF};
    pg8::EpiMix E{(bf16*)(p.ws + WS_Z), (size_t)T * D, D, 0, (pg8::f32x2*)(p.ws + WS_VST), (const float*)(p.ws + WS_HS), (const float*)(p.ws + WS_WSC) + (size_t)l * DIN};
    pg8::gemm_phase<pg8::EpiMix, pg8::InprojOrder, false, 2>(lds_, g, S, E, nullptr, wv_);
}
__device__ __forceinline__ void phase_outproj(const P& p, LAS unsigned char* lds_, int wv_, int l) {
    pg8::Gemm g{(const bf16*)(p.ws + WS_M), (const bf16*)(p.ws + WS_WOUT) + (size_t)l * D * D, D, 0, 0};
    pg8::StaticOrder S; S.init(T, D, gridDim.x, blockIdx.x);
    bf16* xres = (bf16*)(p.ws + WS_XRES); const float* gate = (const float*)(p.ws + WS_MOD) + (size_t)l * 2 * 6144 + 2 * D; float* ssq = (float*)(p.ws + WS_SSQ);
    if (l == 0) { pg8::EpiResidual<true> E{p.in[0], xres, gate, ssq, D, SEQ, 6144, 0}; pg8::gemm_phase<pg8::EpiResidual<true>, pg8::StaticOrder, false>(lds_, g, S, E, nullptr, wv_); }
    else { pg8::EpiResidual<false> E{xres, xres, gate, ssq, D, SEQ, 6144, 0}; pg8::gemm_phase<pg8::EpiResidual<false>, pg8::StaticOrder, false>(lds_, g, S, E, nullptr, wv_); }
}
__device__ __forceinline__ int load_tile_table(const P& p, LAS unsigned char* lds_, int wv_) {
    const int* tab = (const int*)(p.ws + WS_TAB);
    const int ntiles = __builtin_amdgcn_readfirstlane(tab[0]);
    LAS int* te = (LAS int*)(lds_ + pg8::TILE_OFF);
    asm volatile("" : "+s"(wv_)); int t0 = wv_ * 64 + lane_now(); asm volatile("" : "+v"(t0));
    for (int i = t0; i < NTILE_MAX; i += NTHREADS) te[i] = tab[64 + i];
    __syncthreads();
    return ntiles;
}
constexpr int CW_POST = 8192;
__device__ __forceinline__ int moe_nfree(int ntiles) { const int G = gridDim.x; if (G != 256 || ntiles < 512) return 0; const int left = (ntiles * 8) % G; return left ? G - left : 0; }
__device__ __forceinline__ void phase_moe1(const P& p, LAS unsigned char* lds_, int wv_, int l) {
    const int ntiles = load_tile_table(p, lds_, wv_);
    const int nfree = moe_nfree(ntiles);
    unsigned* ctl = (unsigned*)(p.ws + WS_CTL); volatile LAS unsigned* xbw = (volatile LAS unsigned*)(lds_ + LDS_BYTES - 16);
    {
        pg8::Gemm g{(const bf16*)(p.ws + WS_H8), (const bf16*)(p.ws + WS_WGU + (size_t)l * NE * 2 * DFF * D), D, 0, (size_t)2 * DFF * D};
        pg8::Moe1Order S; S.init(ntiles, 2 * DFF / 256, gridDim.x, blockIdx.x, (const LAS int*)(lds_ + pg8::TILE_OFF));
        S.ploc = ctl + CW_POST + 2048 * l; S.ptop = ctl + CW_POST + 2048 * l + 1024; S.st = xbw; S.post_ui = nfree ? 7 : -1;
        pg8::EpiSwiglu E{p.ws + WS_ACT, DFF, 2 * DFF, p.in[15] + (size_t)l * NE * 2 * DFF, 1.0f / WSCALE, ASCALE};
        pg8::gemm_phase<pg8::EpiSwiglu, pg8::Moe1Order, true, true>(lds_, g, S, E, (const int*)(p.ws + WS_ROWTOK), wv_);
    }
    const int e = (int)blockIdx.x - (int)(gridDim.x - nfree);
    if (nfree > 0 && e >= 0) {
        asm volatile("" : "+s"(wv_));
        if (wv_ == 0 && lane_now() == 0) {
            unsigned* bar = ctl + CW_BAR; unsigned* ptop = ctl + CW_POST + 2048 * l + 1024; const unsigned nx = xbw[1];
            XB_SPIN(xb_ld(ptop) < nx, bar);
            __builtin_amdgcn_fence(__ATOMIC_ACQUIRE, "agent");
            asm volatile("s_waitcnt vmcnt(0)" ::: "memory");
        }
        __syncthreads();
        const int x = e & 7, k = e >> 3;
        pg8::EarlyOrder S; S.pm = 8 * pg8::moe_g0(x, ntiles) + (k & 7); S.pn = k >> 3; S.be = __builtin_amdgcn_readfirstlane(((const LAS int*)(lds_ + pg8::TILE_OFF))[S.pm]);
        pg8::Gemm g{(const bf16*)(p.ws + WS_ACT), (const bf16*)(p.ws + WS_WDN + (size_t)l * NE * D * DFF), DFF, 0, (size_t)D * DFF};
        pg8::EpiFp8Out E{p.ws + WS_Y, D, D, p.in[17] + (size_t)l * NE * D, 1.0f / (WSCALE * ASCALE), YSCALE};
        pg8::gemm_phase<pg8::EpiFp8Out, pg8::EarlyOrder, false, true>(lds_, g, S, E, nullptr, wv_);
    }
}
__device__ __forceinline__ void phase_moe2(const P& p, LAS unsigned char* lds_, int wv_, int l) {
    const int ntiles = load_tile_table(p, lds_, wv_);
    pg8::Gemm g{(const bf16*)(p.ws + WS_ACT), (const bf16*)(p.ws + WS_WDN + (size_t)l * NE * D * DFF), DFF, 0, (size_t)D * DFF};
    pg8::Moe2Order S; S.init(ntiles, gridDim.x, blockIdx.x, (const LAS int*)(lds_ + pg8::TILE_OFF), moe_nfree(ntiles));
    pg8::EpiFp8Out E{p.ws + WS_Y, D, D, p.in[17] + (size_t)l * NE * D, 1.0f / (WSCALE * ASCALE), YSCALE};
    pg8::gemm_phase<pg8::EpiFp8Out, pg8::Moe2Order, false, true>(lds_, g, S, E, nullptr, wv_);
}

static_assert((CW_BAR + XCD_BAR_WORDS) * 4 <= (int)CTL_BYTES, "barrier words inside the zeroed region");
__global__ void __launch_bounds__(NTHREADS, 2) k_mega(P p) {
    extern __shared__ __attribute__((aligned(16))) unsigned char lds_raw[];
    LAS unsigned char* const lds = (LAS unsigned char*)lds_raw;
    int wv = __builtin_amdgcn_readfirstlane((int)(threadIdx.x >> 6)); const bool thr0 = threadIdx.x == 0;
    volatile LAS unsigned* xbw = (volatile LAS unsigned*)(lds + LDS_BYTES - 16);
    if (threadIdx.x < 4) xbw[threadIdx.x] = 0u;
    __syncthreads();
    XcdBarrier bar = xcd_barrier_post((unsigned*)(p.ws + WS_CTL) + CW_BAR, xbw);
    phase_prologue(p, lds, wv);
    xcd_barrier(bar, wv);
    for (int l = 0; l < NL; ++l) {
        if (l == 0) phase_norm1<0>(p, lds, wv, l); else phase_norm1<1>(p, lds, wv, l);
        xcd_barrier(bar, wv);
        phase_inproj(p, lds, wv, l);
        xcd_barrier(bar, wv);
        phase_mixer(p, lds, wv, l);
        xcd_barrier(bar, wv);
        phase_outproj(p, lds, wv, l);
        xcd_barrier(bar, wv);
        phase_router(p, lds, wv, l);
        if (gridDim.x != NCHUNK) { xcd_barrier(bar, wv); phase_scatter(p, lds, wv); }
        xcd_barrier(bar, wv);
        phase_moe1(p, lds, wv, l);
        xcd_barrier(bar, wv);
        phase_moe2(p, lds, wv, l);
        xcd_barrier(bar, wv);
    }
    phase_norm1<2>(p, lds, wv, NL);
}

extern "C" void kernel_launch(void* const* d_in, const int* in_sizes, int n_in, void* d_out, int out_size, void* d_ws, size_t ws_size, hipStream_t stream) {
    static int grid = 0;
    if (grid == 0) {
        if (n_in != 19 || in_sizes[0] != T * D || out_size != T * D || ws_size < WS_END) { fprintf(stderr, "kernel_launch: unexpected shapes (n_in %d, in0 %d, out %d, ws %zu < %zu); nothing launched\n", n_in, n_in > 0 ? in_sizes[0] : -1, out_size, ws_size, (size_t)WS_END); grid = -1; return; }
        int dev = 0, cus = 0, per_cu = 0;
        if (hipGetDevice(&dev) != hipSuccess || hipDeviceGetAttribute(&cus, hipDeviceAttributeMultiprocessorCount, dev) != hipSuccess) { grid = -1; return; }
        if (hipFuncSetAttribute((const void*)k_mega, hipFuncAttributeMaxDynamicSharedMemorySize, LDS_BYTES) != hipSuccess) { fprintf(stderr, "kernel_launch: hipFuncSetAttribute failed\n"); grid = -1; return; }
        if (hipOccupancyMaxActiveBlocksPerMultiprocessor(&per_cu, (const void*)k_mega, NTHREADS, LDS_BYTES) != hipSuccess || per_cu < 1) fprintf(stderr, "kernel_launch: occupancy query reports %d blocks per CU\n", per_cu);
        (void)hipGetLastError();
        grid = cus;
    }
    if (grid < 0) return;
    P p{};
    for (int i = 0; i < 19; ++i) p.in[i] = (const float*)d_in[i];
    p.out = (float*)d_out; p.ws = (unsigned char*)d_ws;
    (void)hipMemsetAsync((char*)d_ws + WS_CTL, 0, CTL_BYTES, stream);
    hipLaunchKernelGGL(k_mega, dim3(grid), dim3(NTHREADS), LDS_BYTES, stream, p);
}
```

```cpp
#include <hip/hip_runtime.h>
#include <cstdio>
#include <cstdint>

namespace pg8 {
#define PG8_LAS __attribute__((address_space(3)))
typedef unsigned short bf16_t;
typedef short bf16x8 __attribute__((ext_vector_type(8)));
typedef float f32x4 __attribute__((ext_vector_type(4)));
typedef float f32x2 __attribute__((ext_vector_type(2)));
typedef unsigned u32x4 __attribute__((ext_vector_type(4)));
typedef unsigned u32x2 __attribute__((ext_vector_type(2)));
constexpr int BM = 256, BK = 64, HALF = 128, HTB = HALF * BK * 2  , STAGE_BYTES = 8 * HTB, NXCD = 8, WGM = 8;
constexpr int TILE_OFF = STAGE_BYTES  , TOK_OFF = STAGE_BYTES + 4096  , BIAS_OFF = TOK_OFF + 8192  , ROWS_OFF = BIAS_OFF + 2048  ;

__host__ __device__ __forceinline__ int lds_byte(int r, int c) { const int st = (r >> 4) * 2 + (c >> 5), rr = r & 15, cc = c & 31, ob = rr * 64 + cc * 2; return st * 1024 + (ob ^ (((ob >> 9) & 1) << 5)); }
__host__ __device__ __forceinline__ void stage_rc(int b, int& R, int& C) { const int st = b / 1024, sb = b % 1024, swz = sb ^ (((sb >> 9) & 1) << 5); R = (st >> 1) * 16 + swz / 64; C = (st & 1) * 32 + (swz % 64) / 2; }
__host__ __device__ __forceinline__ int perm32(int rho) { const int n = rho >> 4, i = rho & 15; return 8 * (i >> 2) + 4 * n + (i & 3); }

typedef int i32x8 __attribute__((ext_vector_type(8)));
typedef int i32x4 __attribute__((ext_vector_type(4)));
__device__ __forceinline__ i32x8 cat8(bf16x8 lo, bf16x8 hi) { const i32x4 l = __builtin_bit_cast(i32x4, lo), h = __builtin_bit_cast(i32x4, hi); return __builtin_shufflevector(l, h, 0, 1, 2, 3, 4, 5, 6, 7); }
template <int O> __device__ __forceinline__ float xshfl(float v) {
    if constexpr (O < 32) return __builtin_bit_cast(float, __builtin_amdgcn_ds_swizzle(__builtin_bit_cast(int, v), (O << 10) | 0x1f));
    else { int l; asm volatile("v_mbcnt_lo_u32_b32 %0, -1, 0\n\tv_mbcnt_hi_u32_b32 %0, -1, %0" : "=v"(l)); return __builtin_bit_cast(float, __builtin_amdgcn_ds_bpermute((l ^ 32) << 2, __builtin_bit_cast(int, v))); }
}
struct Unit { int pm, pn, be; };
struct Gemm { const bf16_t* A; const bf16_t* Bt; int K; int pad; size_t bstride; };

struct StaticOrder {
    int nM, nN, nwg, G, c;
    __host__ __device__ void init(int M, int N, int G_, int c_) { nM = M / BM; nN = N / BM; nwg = nM * nN; G = G_; c = c_; }
    __host__ __device__ bool next(int i, Unit& u) const {
        const long L = (long)i * G + c; if (L >= nwg) return false;
        int wgid = (int)L; { const int q = nwg / NXCD, r = nwg % NXCD, xcd = wgid % NXCD, off = wgid / NXCD; wgid = (xcd < r ? xcd * (q + 1) : r * (q + 1) + (xcd - r) * q) + off; }
        const int nig = WGM * nN, gid = wgid / nig, fm = gid * WGM, gsz = (nM - fm) < WGM ? (nM - fm) : WGM;
        u.pm = fm + ((wgid % nig) % gsz); u.pn = (wgid % nig) / gsz; u.be = 0; return true;
    }
    __device__ __forceinline__ void a_ready(const Unit&) const {}
    __device__ __forceinline__ void done(const Unit&) const {}
    __device__ __forceinline__ void after_unit(int, int, int) const {}
    __device__ __forceinline__ void before_epi(int, int, int) const {}
};
constexpr float CV_SCALE = 64.0f;
constexpr float GV_SCALE = 8.0f;
struct CvJob { const float* gu; const float* dn; unsigned char* gu8; unsigned char* dn8; };
struct CvItem { const float* src; unsigned char* dst; int N; };
__device__ __forceinline__ CvItem cv_item(const CvJob& J, int gw, int j) {
    const bool gu = j < 8; const int it = gw + 2048 * j - (gu ? 0 : 16384);
    const int N = gu ? 2048 : 1024, ipm = gu ? 512 : 256, nblk = N / 32, K = 1024;
    const int mi = it / ipm, r = it % ipm, k0 = 128 * (r / nblk), n0 = 32 * (r % nblk);
    const int d0 = gu ? ((n0 & 1023) >> 7) * 256 + (n0 >> 10) * 128 + (n0 & 127) : n0;
    CvItem c; c.src = (gu ? J.gu : J.dn) + (size_t)mi * K * N + (size_t)k0 * N + n0; c.dst = (gu ? J.gu8 : J.dn8) + (size_t)mi * K * N + (size_t)d0 * K + k0; c.N = N; return c;
}
__device__ __forceinline__ void cv_slice1(const CvJob& J, int gw, int j, int lane) {
    const int ng = lane & 7, kq = lane >> 3;
    const CvItem I = cv_item(J, gw, j);
    f32x4 v[16];
    const float* wp = I.src + (size_t)(16 * kq) * I.N + 4 * ng;
#pragma unroll
    for (int i = 0; i < 16; ++i) v[i] = __builtin_nontemporal_load((const f32x4*)(wp + (size_t)i * I.N));
    unsigned char* dst = I.dst + (size_t)(4 * ng) * 1024 + 16 * kq;
#pragma unroll
    for (int c = 0; c < 4; ++c) { unsigned o[4];
#pragma unroll
        for (int t = 0; t < 4; ++t) { o[t] = 0u; o[t] = __builtin_amdgcn_cvt_pk_fp8_f32(v[4 * t][c] * CV_SCALE, v[4 * t + 1][c] * CV_SCALE, o[t], false); o[t] = __builtin_amdgcn_cvt_pk_fp8_f32(v[4 * t + 2][c] * CV_SCALE, v[4 * t + 3][c] * CV_SCALE, o[t], true); }
        __builtin_nontemporal_store((u32x4){o[0], o[1], o[2], o[3]}, (u32x4*)(dst + (size_t)c * 1024)); }
}
constexpr int CV_NI = 1, CV_NSL = 12;
struct InprojOrder : StaticOrder {
    CvJob job; int njobs; int gw0;
    int rot;
    __device__ bool next(int i, Unit& u) const { int ii = i; if (rot > 0 && i < 14) { const int half = i >= 7 ? 1 : 0, k = i - 7 * half; int kk = k + rot; kk = kk >= 7 ? kk - 7 : kk; ii = 7 * half + kk; } return StaticOrder::next(ii, u); }
    __device__ __forceinline__ void before_epi(int ui, int wid, int lane) const {
        if (ui >= CV_NSL * njobs) return;
        const int j0 = CV_NI * ui;
        cv_slice1(job, gw0 + wid, ui, lane);
    }
};

struct GroupedOrder {
    int nM, nN, nwg, G, c; const PG8_LAS int* tile_e;
    __device__ void init(int nM_, int nN_, int G_, int c_, const PG8_LAS int* te) { nM = nM_; nN = nN_; nwg = nM * nN; G = G_; c = c_; tile_e = te; }
    __device__ bool next(int i, Unit& u) const {
        const long L = (long)i * G + c; if (L >= nwg) return false;
        int wgid = (int)L; { const int q = nwg / NXCD, r = nwg % NXCD, xcd = wgid % NXCD, off = wgid / NXCD; wgid = (xcd < r ? xcd * (q + 1) : r * (q + 1) + (xcd - r) * q) + off; }
        const int nig = WGM * nN, gid = wgid / nig, fm = gid * WGM, gsz = (nM - fm) < WGM ? (nM - fm) : WGM;
        u.pm = fm + ((wgid % nig) % gsz); u.pn = (wgid % nig) / gsz;
        u.be = __builtin_amdgcn_readfirstlane(tile_e[u.pm]); return true;
    }
    __device__ __forceinline__ void a_ready(const Unit&) const {}
    __device__ __forceinline__ void done(const Unit&) const {}
    __device__ __forceinline__ void after_unit(int, int, int) const {}
    __device__ __forceinline__ void before_epi(int, int, int) const {}
};
__device__ __forceinline__ int moe_g0(int x, int nM) { return (x * nM + 63) >> 6; }
struct Moe1Order : GroupedOrder {
    unsigned* ploc; unsigned* ptop; volatile PG8_LAS unsigned* st; int post_ui;
    __device__ __forceinline__ void after_unit(int ui, int wid, int lane) const {
        if (ui != post_ui) return;
        asm volatile("s_waitcnt vmcnt(0)" ::: "memory");
        __builtin_amdgcn_s_barrier();
        if (wid == 0 && lane == 0) {
            const unsigned nloc = st[0], x = (unsigned)__builtin_amdgcn_s_getreg((3 << 11) | 20) & 0xFu;
            const unsigned old = __hip_atomic_fetch_add(ploc + 64 * x, 1u, __ATOMIC_RELAXED, __HIP_MEMORY_SCOPE_AGENT);
            if (old + 1u == nloc) { __builtin_amdgcn_fence(__ATOMIC_RELEASE, "agent"); asm volatile("s_waitcnt vmcnt(0)" ::: "memory"); (void)__hip_atomic_fetch_add(ptop, 1u, __ATOMIC_RELAXED, __HIP_MEMORY_SCOPE_AGENT); }
        }
    }
};
struct Moe2Order {
    int nM, nwg, G, c, nfree; const PG8_LAS int* tile_e;
    __device__ void init(int nM_, int G_, int c_, const PG8_LAS int* te, int nfree_) { nM = nM_; nfree = nfree_; nwg = nM * 4 - nfree_; G = G_; c = c_; tile_e = te; }
    __device__ bool next(int i, Unit& u) const {
        const long L = (long)i * G + c; if (L >= nwg) return false;
        int w = (int)L; { const int q = nwg / NXCD, r = nwg % NXCD, xcd = w % NXCD, off = w / NXCD; w = (xcd < r ? xcd * (q + 1) : r * (q + 1) + (xcd - r) * q) + off; }
#pragma unroll
        for (int x = 0; x < 8; ++x) { const int nx_ = nfree > x ? (nfree - x + 7) >> 3 : 0; if (w >= 32 * moe_g0(x, nM)) w += nx_; }
        const int gid = w / 32, fm = gid * WGM, gsz = (nM - fm) < WGM ? (nM - fm) : WGM;
        u.pm = fm + ((w % 32) % gsz); u.pn = (w % 32) / gsz;
        u.be = __builtin_amdgcn_readfirstlane(tile_e[u.pm]); return true;
    }
    __device__ __forceinline__ void a_ready(const Unit&) const {}
    __device__ __forceinline__ void done(const Unit&) const {}
    __device__ __forceinline__ void after_unit(int, int, int) const {}
    __device__ __forceinline__ void before_epi(int, int, int) const {}
};
struct EarlyOrder {
    int pm, pn, be;
    __device__ bool next(int i, Unit& u) const { if (i != 0) return false; u.pm = pm; u.pn = pn; u.be = be; return true; }
    __device__ __forceinline__ void a_ready(const Unit&) const {}
    __device__ __forceinline__ void done(const Unit&) const {}
    __device__ __forceinline__ void after_unit(int, int, int) const {}
    __device__ __forceinline__ void before_epi(int, int, int) const {}
};

__device__ __forceinline__ unsigned cvt_pk_bf16(float lo, float hi) { unsigned r; asm volatile("v_cvt_pk_bf16_f32 %0, %1, %2" : "=v"(r) : "v"(lo), "v"(hi)); return r; }

struct EpiFp8Out {
    static constexpr bool PERM = true, AFTER_DRAIN = false, HAS_BIAS = true, HAS_ROWSCALE = false;
    unsigned char* O; int ldc; int bias_stride; const float* bias; float scale, oscale;
    __device__ __forceinline__ const float* rowscale_ptr(const Unit&, int, int, int) const { return nullptr; }
    __device__ __forceinline__ const float* bias_ptr(const Unit& u, int wc, int lane) const { return bias + (size_t)u.be * bias_stride + u.pn * BM + (lane >> 5) * HALF + wc * 32 + (lane & 31); }
    __device__ __forceinline__ void operator()(const f32x4 (&acc)[2][2][4][2], const Unit& u, int wr, int wc, int fr, int fq, const PG8_LAS float* bl, const PG8_LAS float*) const {
        const int row0 = u.pm * BM + wr * 64 + fr; const int col0 = u.pn * BM + wc * 32 + 8 * fq;
        f32x4 bv[2][2]; const float so = scale * oscale;
#pragma unroll
        for (int bj = 0; bj < 2; ++bj)
#pragma unroll
            for (int n = 0; n < 2; ++n) bv[bj][n] = *(const PG8_LAS f32x4*)(bl + 32 * bj + 8 * fq + 4 * n) * oscale;
#pragma unroll
        for (int ai = 0; ai < 2; ++ai)
#pragma unroll
            for (int m = 0; m < 4; ++m) { unsigned char* rowp = O + (size_t)(row0 + ai * HALF + m * 16) * ldc + col0;
#pragma unroll
                for (int bj = 0; bj < 2; ++bj) { const f32x4 v0 = acc[ai][bj][m][0] * so + bv[bj][0], v1 = acc[ai][bj][m][1] * so + bv[bj][1];
                    u32x2 w; w.x = 0u; w.y = 0u;
                    w.x = __builtin_amdgcn_cvt_pk_fp8_f32(v0[0], v0[1], w.x, false); w.x = __builtin_amdgcn_cvt_pk_fp8_f32(v0[2], v0[3], w.x, true);
                    w.y = __builtin_amdgcn_cvt_pk_fp8_f32(v1[0], v1[1], w.y, false); w.y = __builtin_amdgcn_cvt_pk_fp8_f32(v1[2], v1[3], w.y, true);
                    *(u32x2*)(rowp + bj * HALF) = w; } }
    }
};
template <bool BASE32>
struct EpiResidual {
    static constexpr bool PERM = true, AFTER_DRAIN = false, HAS_BIAS = false, HAS_ROWSCALE = false;
    const void* base; bf16_t* out; const float* gate; float* ssq; int ldc; int rows_per_batch; int gate_stride; int pad; float ascale;
    __device__ __forceinline__ const float* rowscale_ptr(const Unit&, int, int, int) const { return nullptr; }
    __device__ __forceinline__ const float* bias_ptr(const Unit&, int, int) const { return nullptr; }
    __device__ __forceinline__ void operator()(const f32x4 (&acc)[2][2][4][2], const Unit& u, int wr, int wc, int fr, int fq, const PG8_LAS float*, const PG8_LAS float*) const {
        const int row0 = u.pm * BM + wr * 64 + fr, col0 = u.pn * BM + wc * 32 + 8 * fq;
        const float* gp = gate + (size_t)((u.pm * BM) / rows_per_batch) * gate_stride;
        f32x4 gv[2][2];
#pragma unroll
        for (int bj = 0; bj < 2; ++bj)
#pragma unroll
            for (int n = 0; n < 2; ++n) gv[bj][n] = *(const f32x4*)(gp + col0 + bj * HALF + 4 * n) * ascale;
#pragma unroll
        for (int ai = 0; ai < 2; ++ai) {
          u32x4 qb[4][2];
          if (!BASE32) {
#pragma unroll
            for (int m = 0; m < 4; ++m)
#pragma unroll
                for (int bj = 0; bj < 2; ++bj) qb[m][bj] = *(const u32x4*)((const bf16_t*)base + (size_t)(row0 + ai * HALF + m * 16) * ldc + col0 + bj * HALF);
          }
#pragma unroll
            for (int m = 0; m < 4; ++m) { const int row = row0 + ai * HALF + m * 16; const size_t off = (size_t)row * ldc + col0; float s = 0.f;
#pragma unroll
                for (int bj = 0; bj < 2; ++bj) { f32x4 b0, b1;
                    if (BASE32) { b0 = *(const f32x4*)((const float*)base + off + bj * HALF); b1 = *(const f32x4*)((const float*)base + off + bj * HALF + 4); }
                    else { const u32x4 q = qb[m][bj];
                        b0 = (f32x4){__builtin_bit_cast(float, q.x << 16), __builtin_bit_cast(float, q.x & 0xffff0000u), __builtin_bit_cast(float, q.y << 16), __builtin_bit_cast(float, q.y & 0xffff0000u)};
                        b1 = (f32x4){__builtin_bit_cast(float, q.z << 16), __builtin_bit_cast(float, q.z & 0xffff0000u), __builtin_bit_cast(float, q.w << 16), __builtin_bit_cast(float, q.w & 0xffff0000u)}; }
                    const f32x4 o0 = b0 + gv[bj][0] * acc[ai][bj][m][0], o1 = b1 + gv[bj][1] * acc[ai][bj][m][1];
                    s += ((o0[0] * o0[0] + o0[1] * o0[1]) + (o0[2] * o0[2] + o0[3] * o0[3])) + ((o1[0] * o1[0] + o1[1] * o1[1]) + (o1[2] * o1[2] + o1[3] * o1[3]));
                    u32x4 w; w.x = cvt_pk_bf16(o0[0], o0[1]); w.y = cvt_pk_bf16(o0[2], o0[3]); w.z = cvt_pk_bf16(o1[0], o1[1]); w.w = cvt_pk_bf16(o1[2], o1[3]);
                    *(u32x4*)(out + off + bj * HALF) = w; }
                s += xshfl<16>(s); s += xshfl<32>(s);
                if (fq == 0) ssq[(size_t)row * 16 + u.pn * 4 + wc] = s;
                if (BASE32) asm volatile("" ::: "memory"); }
          asm volatile("" ::: "memory");
        }
    }
};

struct EpiSwiglu {
    static constexpr bool PERM = true, AFTER_DRAIN = false, HAS_BIAS = true, HAS_ROWSCALE = false;
    unsigned char* O; int ldc; int bias_stride; const float* bias; float iscale, oscale;
    __device__ __forceinline__ const float* rowscale_ptr(const Unit&, int, int, int) const { return nullptr; }
    __device__ __forceinline__ const float* bias_ptr(const Unit& u, int wc, int lane) const { return bias + (size_t)u.be * bias_stride + (lane >> 5) * ldc + u.pn * HALF + wc * 32 + (lane & 31); }
    __device__ __forceinline__ void operator()(const f32x4 (&acc)[2][2][4][2], const Unit& u, int wr, int wc, int fr, int fq, const PG8_LAS float* bl, const PG8_LAS float*) const {
        const int row0 = u.pm * BM + wr * 64 + fr; const int col0 = u.pn * HALF + wc * 32 + 8 * fq;
        f32x4 bg[2], bu[2];
#pragma unroll
        for (int n = 0; n < 2; ++n) { bg[n] = *(const PG8_LAS f32x4*)(bl + 8 * fq + 4 * n); bu[n] = *(const PG8_LAS f32x4*)(bl + 32 + 8 * fq + 4 * n); }
#pragma unroll
        for (int ai = 0; ai < 2; ++ai)
#pragma unroll
            for (int m = 0; m < 4; ++m) { unsigned char* rowp = O + (size_t)(row0 + ai * HALF + m * 16) * ldc + col0; float r[8];
#pragma unroll
                for (int n = 0; n < 2; ++n) { const f32x4 gv = acc[ai][0][m][n] * iscale + bg[n], uv = acc[ai][1][m][n] * iscale + bu[n];
#pragma unroll
                    for (int j = 0; j < 4; ++j) { const float gt = fminf(gv[j], 7.0f), up = fminf(fmaxf(uv[j], -7.0f), 7.0f);
                        r[4 * n + j] = gt * __builtin_amdgcn_rcpf(1.0f + __builtin_amdgcn_exp2f(gt * (-1.702f * 1.44269504f))) * __builtin_fmaf(up, oscale, oscale); } }
                u32x2 w; w.x = 0u; w.y = 0u;
                w.x = __builtin_amdgcn_cvt_pk_fp8_f32(r[0], r[1], w.x, false); w.x = __builtin_amdgcn_cvt_pk_fp8_f32(r[2], r[3], w.x, true);
                w.y = __builtin_amdgcn_cvt_pk_fp8_f32(r[4], r[5], w.y, false); w.y = __builtin_amdgcn_cvt_pk_fp8_f32(r[6], r[7], w.y, true);
                *(u32x2*)rowp = w; }
    }
};

__device__ __forceinline__ f32x2 gelu_pk(f32x2 v) {
    const f32x2 av = __builtin_elementwise_abs(v), d = av * 0.2316418882f + 1.0f;
    f32x2 t; t.x = __builtin_amdgcn_rcpf(d.x); t.y = __builtin_amdgcn_rcpf(d.y);
    f32x2 q = t * 0.5307027145f + (-0.7265760135f); q = q * t + 0.7107068705f; q = q * t + (-0.142248368f); q = q * t + 0.127414796f; q = q * t;
    const f32x2 s = (v * v) * (-0.72134752044f);
    f32x2 e; e.x = __builtin_amdgcn_exp2f(s.x); e.y = __builtin_amdgcn_exp2f(s.y);
    const f32x2 qe = q * e; f32x2 mx; mx.x = fmaxf(v.x, 0.f); mx.y = fmaxf(v.y, 0.f);
    return mx - av * qe;
}
__device__ __forceinline__ f32x4 gelu4(f32x4 v) { const f32x2 a = gelu_pk((f32x2){v[0], v[1]}), b = gelu_pk((f32x2){v[2], v[3]}); return (f32x4){a.x, a.y, b.x, b.y}; }
__device__ __forceinline__ f32x4 sigmoid4n(f32x4 t) { f32x4 o;
#pragma unroll
    for (int j = 0; j < 4; ++j) o[j] = __builtin_amdgcn_rcpf(1.0f + __builtin_amdgcn_exp2f(t[j])); return o; }

struct EpiMix {
    static constexpr bool PERM = true, AFTER_DRAIN = false, HAS_BIAS = true, HAS_ROWSCALE = true;
    bf16_t* O; size_t plane; int ldc; int pad; f32x2* vst;
    const float* rowscale; const float* colscale;
    __device__ __forceinline__ const float* rowscale_ptr(const Unit& u, int ai, int wr, int lane) const { return rowscale + u.pm * BM + ai * HALF + wr * 64 + lane; }
    __device__ __forceinline__ const float* bias_ptr(const Unit& u, int wc, int lane) const { return colscale + u.pn * BM + (lane >> 5) * HALF + wc * 32 + (lane & 31); }
    static __device__ __forceinline__ f32x4 deq(const f32x4 a, const float sr, const f32x4 sc) { const i32x4 i = __builtin_bit_cast(i32x4, a); return (f32x4){(float)i[0], (float)i[1], (float)i[2], (float)i[3]} * sr * sc; }
    __device__ __forceinline__ void operator()(const f32x4 (&acc)[2][2][4][2], const Unit& u, int wr, int wc, int fr, int fq, const PG8_LAS float* bl, const PG8_LAS float* rs) const {
        const int row0 = u.pm * BM + wr * 64 + fr, lc = wc * 32 + 8 * fq, ty = u.pn >> 3;
        f32x4 sc[2][2];
#pragma unroll
        for (int bj = 0; bj < 2; ++bj)
#pragma unroll
            for (int n = 0; n < 2; ++n) sc[bj][n] = *(const PG8_LAS f32x4*)(bl + 32 * bj + 8 * fq + 4 * n);
        if (ty == 1 || ty == 2) { sc[1][0] = sc[1][0] * -1.44269504f; sc[1][1] = sc[1][1] * -1.44269504f; }
        if (ty < 3) {
            bf16_t* base = O + (size_t)ty * plane + (u.pn & 7) * HALF + lc;
#pragma unroll
            for (int ai = 0; ai < 2; ++ai)
#pragma unroll
                for (int m = 0; m < 4; ++m) { bf16_t* rowp = base + (size_t)(row0 + ai * HALF + m * 16) * ldc; f32x4 r[2];
#pragma unroll
                    for (int n = 0; n < 2; ++n) { const float sr = rs[ai * 64 + m * 16 + fr]; const f32x4 x0 = deq(acc[ai][0][m][n], sr, sc[0][n]), x1 = deq(acc[ai][1][m][n], sr, sc[1][n]);
                        if (ty == 0) r[n] = x0 * x1; else if (ty == 1) r[n] = x0 * sigmoid4n(x1); else r[n] = gelu4(x0) * sigmoid4n(x1); }
                    u32x4 w; w.x = cvt_pk_bf16(r[0][0], r[0][1]); w.y = cvt_pk_bf16(r[0][2], r[0][3]); w.z = cvt_pk_bf16(r[1][0], r[1][1]); w.w = cvt_pk_bf16(r[1][2], r[1][3]);
                    *(u32x4*)rowp = w; }
        } else {
            unsigned char* base = (unsigned char*)(O + (size_t)3 * plane) + (u.pn - 24) * BM + lc;
#pragma unroll
            for (int ai = 0; ai < 2; ++ai)
#pragma unroll
                for (int m = 0; m < 4; ++m) { const int row = row0 + ai * HALF + m * 16; unsigned char* rowp = base + (size_t)row * ldc; float s = 0.f, q = 0.f;
#pragma unroll
                    for (int bj = 0; bj < 2; ++bj) { const float sr = rs[ai * 64 + m * 16 + fr]; const f32x4 g0 = gelu4(deq(acc[ai][bj][m][0], sr, sc[bj][0])), g1 = gelu4(deq(acc[ai][bj][m][1], sr, sc[bj][1]));
                        s += ((g0[0] + g0[1]) + (g0[2] + g0[3])) + ((g1[0] + g1[1]) + (g1[2] + g1[3]));
                        q += ((g0[0] * g0[0] + g0[1] * g0[1]) + (g0[2] * g0[2] + g0[3] * g0[3])) + ((g1[0] * g1[0] + g1[1] * g1[1]) + (g1[2] * g1[2] + g1[3] * g1[3]));
                        u32x2 w; w.x = 0u; w.y = 0u;
                        w.x = __builtin_amdgcn_cvt_pk_fp8_f32(g0[0] * GV_SCALE, g0[1] * GV_SCALE, w.x, false); w.x = __builtin_amdgcn_cvt_pk_fp8_f32(g0[2] * GV_SCALE, g0[3] * GV_SCALE, w.x, true);
                        w.y = __builtin_amdgcn_cvt_pk_fp8_f32(g1[0] * GV_SCALE, g1[1] * GV_SCALE, w.y, false); w.y = __builtin_amdgcn_cvt_pk_fp8_f32(g1[2] * GV_SCALE, g1[3] * GV_SCALE, w.y, true);
                        *(u32x2*)(rowp + bj * HALF) = w; }
                    s += xshfl<16>(s); s += xshfl<32>(s); q += xshfl<16>(q); q += xshfl<32>(q);
                    if (fq == 0) vst[(size_t)row * 16 + (u.pn - 24) * 4 + wc] = (f32x2){s, q}; }
        }
    }
};

template <class Epi, class Sched, bool GATHER, int OPK = 0>
__device__ __forceinline__ void gemm_phase(PG8_LAS unsigned char* lds, const Gemm g, const Sched& S, const Epi& E, const int* rowtok, int wv_) {
    asm volatile("" : "+s"(wv_)); int lane_; asm volatile("v_mbcnt_lo_u32_b32 %0, -1, 0\n\tv_mbcnt_hi_u32_b32 %0, -1, %0" : "=v"(lane_)); int tid_ = wv_ * 64 + lane_; asm volatile("" : "+v"(tid_));
    constexpr bool FP8 = (OPK == 1), I8 = (OPK == 2);
    const int tid = tid_, wid = __builtin_amdgcn_readfirstlane(tid >> 6), lane = tid & 63, wr = wid >> 2, wc = wid & 3, fr = lane & 15, fq = lane >> 4;
    const int K = g.K, rowb = (OPK != 0) ? K : K * 2  , nt = rowb / (BK * 2);
    const size_t kstep = (size_t)(BK * 2);
    const size_t hstep = (size_t)HALF * rowb;
    const size_t tstep = 2 * hstep;
    unsigned voffB[2], voA[2][2]; int RA[2]; unsigned CA[2];
#pragma unroll
    for (int i = 0; i < 2; ++i) { int R, C; stage_rc(tid * 16 + i * 8192, R, C); const int Rb = Epi::PERM ? ((R & ~31) + perm32(R & 31)) : R;
        voffB[i] = (unsigned)(Rb * rowb + C * 2); RA[i] = R; CA[i] = (unsigned)C * 2u;
        voA[0][i] = (unsigned)(R * rowb + C * 2); voA[1][i] = voA[0][i] + (unsigned)hstep; }
    const unsigned ldsw = (unsigned)wid * 1024u;
    const int aoff = FP8 ? lds_byte(wr * 64 + fr, fq * 16) : lds_byte(wr * 64 + fr, fq * 8), boff = FP8 ? lds_byte(wc * 32 + fr, fq * 16) : lds_byte(wc * 32 + fr, fq * 8);
#define PG8_SA(b, h) (((b) * 2 + (h)) * HTB)
#define PG8_SB(b, h) ((4 + (b) * 2 + (h)) * HTB)
#define PG8_STAGE(bufoff, gbase, voff) do { _Pragma("unroll") for (int _i = 0; _i < 2; ++_i) \
        __builtin_amdgcn_global_load_lds((const unsigned*)((const char*)(gbase) + (voff)[_i]), (PG8_LAS unsigned*)(lds + (bufoff) + ldsw + _i * 8192), 16, 0, 0); } while (0)
#define PG8_LD8(dst, off) do { const i32x4 lo_ = *(const PG8_LAS i32x4*)(lds + (off)), hi_ = *(const PG8_LAS i32x4*)(lds + (off) + 16); dst = __builtin_shufflevector(lo_, hi_, 0, 1, 2, 3, 4, 5, 6, 7); } while (0)
#define PG8_LDA(dst, b, h) do { if constexpr (FP8) { _Pragma("unroll") for (int m = 0; m < 4; ++m) PG8_LD8(dst##8[m], PG8_SA(b, h) + aoff + m * 2048); } else { \
        _Pragma("unroll") for (int m = 0; m < 4; ++m) _Pragma("unroll") for (int k = 0; k < 2; ++k) dst[m][k] = *(const PG8_LAS bf16x8*)(lds + PG8_SA(b, h) + aoff + m * 2048 + k * 1024); } } while (0)
#define PG8_LDB(dst, b, h) do { if constexpr (FP8) { _Pragma("unroll") for (int n = 0; n < 2; ++n) PG8_LD8(dst##8[n], PG8_SB(b, h) + boff + n * 2048); } else { \
        _Pragma("unroll") for (int n = 0; n < 2; ++n) _Pragma("unroll") for (int k = 0; k < 2; ++k) dst[n][k] = *(const PG8_LAS bf16x8*)(lds + PG8_SB(b, h) + boff + n * 2048 + k * 1024); } } while (0)
#define PG8_MMA(ai, bj, At, Bt) do { __builtin_amdgcn_s_setprio(1); if constexpr (FP8) { _Pragma("unroll") for (int m = 0; m < 4; ++m) _Pragma("unroll") for (int n = 0; n < 2; ++n) \
        asm volatile("v_mfma_scale_f32_16x16x128_f8f6f4 %0, %1, %2, %0, %3, %3 op_sel_hi:[0,0,0]" : "+v"(acc[ai][bj][m][n]) : "v"(Bt##8[n]), "v"(At##8[m]), "v"(one8)); } \
        else if constexpr (I8) { _Pragma("unroll") for (int m = 0; m < 4; ++m) _Pragma("unroll") for (int n = 0; n < 2; ++n) _Pragma("unroll") for (int k = 0; k < 2; ++k) \
        acc[ai][bj][m][n] = __builtin_bit_cast(f32x4, __builtin_amdgcn_mfma_i32_16x16x64_i8(__builtin_bit_cast(i32x4, Bt[n][k]), __builtin_bit_cast(i32x4, At[m][k]), __builtin_bit_cast(i32x4, acc[ai][bj][m][n]), 0, 0, 0)); } \
        else { _Pragma("unroll") for (int m = 0; m < 4; ++m) _Pragma("unroll") for (int n = 0; n < 2; ++n) _Pragma("unroll") for (int k = 0; k < 2; ++k) \
        acc[ai][bj][m][n] = __builtin_amdgcn_mfma_f32_16x16x32_bf16(Bt[n][k], At[m][k], acc[ai][bj][m][n], 0, 0, 0); } __builtin_amdgcn_s_setprio(0); } while (0)
#define PG8_WAIT_V(n) asm volatile("s_waitcnt vmcnt(" #n ")" ::: "memory")
#define PG8_WAIT_L(n) asm volatile("s_waitcnt lgkmcnt(" #n ")" ::: "memory")
#define PG8_BAR __builtin_amdgcn_s_barrier()
#define PG8_SCHED __builtin_amdgcn_sched_barrier(0)
#define PG8_TOKLOAD(pm_) do { _Pragma("unroll") for (int _h = 0; _h < 2; ++_h) _Pragma("unroll") for (int _i = 0; _i < 2; ++_i) \
        __builtin_amdgcn_global_load_lds((const unsigned*)(rowtok + (size_t)(pm_) * BM + _h * HALF + RA[_i]), (PG8_LAS unsigned*)(lds + TOK_OFF + wid * 1024 + (_h * 2 + _i) * 256), 4, 0, 0); } while (0)
#define PG8_TOKREAD(dst) do { _Pragma("unroll") for (int _h = 0; _h < 2; ++_h) _Pragma("unroll") for (int _i = 0; _i < 2; ++_i) \
        dst[_h][_i] = (unsigned)(*(const PG8_LAS int*)(lds + TOK_OFF + wid * 1024 + (_h * 2 + _i) * 256 + lane * 4)) * (unsigned)rowb + CA[_i]; } while (0)
#define PG8_BIASLOAD(u_) do { if constexpr (Epi::HAS_BIAS) { int lb_ = lane; asm volatile("" : "+v"(lb_));     \
        __builtin_amdgcn_global_load_lds((const unsigned*)E.bias_ptr(u_, wc, lb_), (PG8_LAS unsigned*)(lds + BIAS_OFF + wid * 256), 4, 0, 0); } } while (0)
#define PG8_ROWSLOAD(u_) do { if constexpr (Epi::HAS_ROWSCALE) { int lr_ = lane; asm volatile("" : "+v"(lr_)); _Pragma("unroll") for (int _ai = 0; _ai < 2; ++_ai) \
        __builtin_amdgcn_global_load_lds((const unsigned*)E.rowscale_ptr(u_, _ai, wr, lr_), (PG8_LAS unsigned*)(lds + ROWS_OFF + wid * 512 + _ai * 256), 4, 0, 0); } } while (0)
    Unit cur, nxt; int ui = 0;
    if (!S.next(0, cur)) return;
    f32x4 acc[2][2][4][2];
#pragma unroll
    for (int a = 0; a < 2; ++a)
#pragma unroll
        for (int b = 0; b < 2; ++b)
#pragma unroll
            for (int m = 0; m < 4; ++m)
#pragma unroll
                for (int n = 0; n < 2; ++n) acc[a][b][m][n] = (f32x4){0.f, 0.f, 0.f, 0.f};
    int one8 = 0x7f7f7f7f; asm volatile("" : "+v"(one8));
    bf16x8 At[4][2], B0[2][2], B1[2][2]; i32x8 At8[4], B08[2], B18[2];
    if constexpr (GATHER) { PG8_TOKLOAD(cur.pm); asm volatile("s_waitcnt vmcnt(0)" ::: "memory"); PG8_TOKREAD(voA); }
    const char* cA = GATHER ? (const char*)g.A : (const char*)g.A + (size_t)cur.pm * tstep; const char* cB = (const char*)g.Bt + (size_t)cur.be * g.bstride + (size_t)cur.pn * tstep;
    S.a_ready(cur);
    PG8_BIASLOAD(cur); PG8_ROWSLOAD(cur);
    PG8_STAGE(PG8_SB(0, 0), cB, voffB); PG8_STAGE(PG8_SB(0, 1), cB + hstep, voffB); PG8_STAGE(PG8_SA(0, 0), cA, voA[0]); PG8_STAGE(PG8_SA(0, 1), cA, voA[1]);
    if (wr == 1) PG8_BAR;
    PG8_WAIT_V(2); PG8_BAR;
    PG8_STAGE(PG8_SB(1, 0), cB + kstep, voffB); PG8_STAGE(PG8_SA(1, 0), cA + kstep, voA[0]); PG8_STAGE(PG8_SB(1, 1), cB + hstep + kstep, voffB);
    PG8_WAIT_V(6); PG8_BAR;
    for (;;) {
        const bool has_next = S.next(ui + 1, nxt);
        const char* nA = (has_next && !GATHER) ? (const char*)g.A + (size_t)nxt.pm * tstep : cA; const char* nB = has_next ? (const char*)g.Bt + (size_t)nxt.be * g.bstride + (size_t)nxt.pn * tstep : cB;
        if constexpr (GATHER) { if (has_next) PG8_TOKLOAD(nxt.pm); }
#pragma unroll 1
        for (int t = 0; t < nt; t += 2) {
            const bool last = (t == nt - 2);
            const char* a1 = cA + (size_t)(t + 1) * kstep;
            const char* a2 = last ? nA : cA + (size_t)(t + 2) * kstep; const char* b2 = last ? nB : cB + (size_t)(t + 2) * kstep;
            const char* a3 = a2 + kstep; const char* b3 = b2 + kstep;
            if (last && has_next) S.a_ready(nxt);
            unsigned vo2[2][2];
#pragma unroll
            for (int h = 0; h < 2; ++h)
#pragma unroll
                for (int i = 0; i < 2; ++i) vo2[h][i] = voA[h][i];
            if constexpr (GATHER) { if (last && has_next) { PG8_TOKREAD(vo2); } }
            PG8_LDB(B0, 0, 0); PG8_LDB(B1, 0, 1); PG8_SCHED; PG8_LDA(At, 0, 0); PG8_STAGE(PG8_SA(1, 1), a1, voA[1]);
            PG8_WAIT_V(8); PG8_WAIT_L(0); PG8_BAR; PG8_MMA(0, 0, At, B0); PG8_MMA(0, 1, At, B1); PG8_BAR; PG8_SCHED;
            PG8_LDA(At, 0, 1); PG8_STAGE(PG8_SB(0, 0), b2, voffB); PG8_STAGE(PG8_SB(0, 1), b2 + hstep, voffB); PG8_STAGE(PG8_SA(0, 0), a2, vo2[0]);
            PG8_WAIT_V(8); PG8_WAIT_L(0); PG8_BAR; PG8_MMA(1, 0, At, B0); PG8_MMA(1, 1, At, B1); PG8_BAR; PG8_SCHED;
            PG8_LDB(B0, 1, 0); PG8_LDB(B1, 1, 1); PG8_SCHED; PG8_LDA(At, 1, 0); PG8_STAGE(PG8_SA(0, 1), a2, vo2[1]);
            PG8_WAIT_V(8); PG8_WAIT_L(0); PG8_BAR; PG8_MMA(0, 0, At, B0); PG8_MMA(0, 1, At, B1); PG8_BAR; PG8_SCHED;
            PG8_LDA(At, 1, 1); PG8_STAGE(PG8_SB(1, 0), b3, voffB); PG8_STAGE(PG8_SB(1, 1), b3 + hstep, voffB); PG8_STAGE(PG8_SA(1, 0), a3, vo2[0]);
            PG8_WAIT_V(8); PG8_WAIT_L(0); PG8_BAR; PG8_MMA(1, 0, At, B0); PG8_MMA(1, 1, At, B1); PG8_BAR; PG8_SCHED;
        }
        if constexpr (FP8) asm volatile("s_nop 15\n\ts_nop 15" ::: "memory");
        if (wr == 0) PG8_BAR;
        S.before_epi(ui, wid, lane);
        if constexpr (!Epi::AFTER_DRAIN) { E(acc, cur, wr, wc, fr, fq, (const PG8_LAS float*)(lds + BIAS_OFF + wid * 256), (const PG8_LAS float*)(lds + ROWS_OFF + wid * 512)); S.done(cur); S.after_unit(ui, wid, lane); }
        if (!has_next) break;
#pragma unroll
        for (int a = 0; a < 2; ++a)
#pragma unroll
            for (int b = 0; b < 2; ++b)
#pragma unroll
                for (int m = 0; m < 4; ++m)
#pragma unroll
                    for (int n = 0; n < 2; ++n) acc[a][b][m][n] = (f32x4){0.f, 0.f, 0.f, 0.f};
        cur = nxt; cA = nA; cB = nB; ++ui;
        PG8_BIASLOAD(cur); PG8_ROWSLOAD(cur);
        if constexpr (GATHER) { PG8_TOKREAD(voA); }
        if (wr == 1) PG8_BAR;
    }
    PG8_WAIT_V(0);
    PG8_BAR;
#undef PG8_SA
#undef PG8_SB
#undef PG8_STAGE
#undef PG8_LDA
#undef PG8_LD8
#undef PG8_LDB
#undef PG8_MMA
#undef PG8_WAIT_V
#undef PG8_WAIT_L
#undef PG8_BAR
#undef PG8_SCHED
#undef PG8_TOKLOAD
#undef PG8_BIASLOAD
#undef PG8_ROWSLOAD
#undef PG8_TOKREAD
}
}

#define LAS __attribute__((address_space(3)))
typedef unsigned short bf16;
typedef float f32x4 __attribute__((ext_vector_type(4)));
typedef unsigned u32x4 __attribute__((ext_vector_type(4)));
typedef unsigned u32x2 __attribute__((ext_vector_type(2)));
constexpr int NB = 2, SEQ = 16384, T = NB * SEQ, D = 1024, DIN = 7168, NE = 32, TOPK = 4, DFF = 1024, NL = 4, CHK = 128, NG = 8;
constexpr int NCHUNK = T / CHK;
constexpr int NASSIGN = T * TOPK;
constexpr int NTILE_MAX = NASSIGN / 256 + NE;
constexpr int NROW_MAX = NTILE_MAX * 256;
constexpr float EPS = 1e-6f;
constexpr float GVSCALE = pg8::GV_SCALE;
constexpr float MSCALE = 16.0f;
constexpr float WSCALE = 64.0f, ASCALE = 4.0f, YSCALE = 8.0f; static_assert(WSCALE == pg8::CV_SCALE, "one weight pre-scale");
constexpr int NWAVES = 8, NTHREADS = 512;
constexpr int LDS_BYTES = 163840;

constexpr size_t al4k(size_t x) { return (x + 4095) & ~(size_t)4095; }
constexpr size_t WS_CTL = 0, CTL_BYTES = 1u << 20;
constexpr size_t WS_MOD = WS_CTL + CTL_BYTES;
constexpr size_t WS_RTH = WS_MOD + al4k((size_t)NL * 2 * 6144 * 4);
constexpr size_t WS_RTL = WS_RTH + al4k((size_t)NL * NE * D * 2);
constexpr size_t WS_SSQ = WS_RTL + al4k((size_t)NL * NE * D * 2);
constexpr size_t WS_CNT = WS_SSQ + al4k((size_t)T * 16 * 4);
constexpr size_t WS_TAB = WS_CNT + al4k((size_t)NCHUNK * NE * 4);
constexpr size_t WS_AE = WS_TAB + al4k(4096);
constexpr size_t WS_AR = WS_AE + al4k((size_t)NASSIGN * 4);
constexpr size_t WS_AW = WS_AR + al4k((size_t)NASSIGN * 4);
constexpr size_t WS_AROW = WS_AW + al4k((size_t)NASSIGN * 4);
constexpr size_t WS_ROWTOK = WS_AROW + al4k((size_t)NASSIGN * 4);
constexpr size_t WS_WIN = WS_ROWTOK + al4k((size_t)NROW_MAX * 4);
constexpr size_t WS_WOUT = WS_WIN + al4k((size_t)NL * DIN * D * 2);
constexpr size_t WS_WGU = WS_WOUT + al4k((size_t)NL * D * D * 2);
constexpr size_t WS_WDN = WS_WGU + al4k((size_t)NL * NE * 2 * DFF * D);
constexpr size_t WS_H8 = WS_WDN + al4k((size_t)NL * NE * D * DFF);
constexpr size_t WS_XRES = WS_H8 + al4k((size_t)T * D);
constexpr size_t WS_H = WS_XRES + al4k((size_t)T * D * 2);
constexpr size_t WS_Z = WS_H + al4k((size_t)T * D * 2);
constexpr size_t WS_VST = WS_Z + al4k((size_t)4 * T * D * 2);
constexpr size_t WS_WSB = WS_VST + al4k((size_t)T * 16 * 8);
constexpr size_t WS_HS = WS_WSB + al4k((size_t)NL * NG * CHK * CHK * 2);
constexpr size_t WS_WSC = WS_HS + al4k((size_t)T * 4);
constexpr size_t WS_M = WS_WSC + al4k((size_t)NL * DIN * 4);
constexpr size_t WS_XB = WS_M + al4k((size_t)T * D * 2);
constexpr size_t WS_GU = WS_XB + al4k((size_t)NROW_MAX * D * 2);
constexpr size_t WS_ACT = WS_GU + al4k((size_t)NROW_MAX * 2 * DFF * 2);
constexpr size_t WS_Y = WS_ACT + al4k((size_t)NROW_MAX * DFF * 2);
constexpr size_t WS_END = WS_Y + al4k((size_t)NROW_MAX * D * 2);

struct P { const float* in[19]; float* out; unsigned char* ws; };

__device__ __forceinline__ unsigned f2bf(float f) { unsigned u = __builtin_bit_cast(unsigned, f); return (u + 0x7fffu + ((u >> 16) & 1u)) >> 16; }
__device__ __forceinline__ unsigned pk2(float lo, float hi) { unsigned r; asm("v_cvt_pk_bf16_f32 %0, %1, %2" : "=v"(r) : "v"(lo), "v"(hi)); return r; }
__device__ __forceinline__ float bf2f(unsigned short b) { return __builtin_bit_cast(float, (unsigned)b << 16); }
__device__ __forceinline__ float bflo(unsigned w) { return __builtin_bit_cast(float, w << 16); }
__device__ __forceinline__ float bfhi(unsigned w) { return __builtin_bit_cast(float, w & 0xffff0000u); }
__device__ __forceinline__ float wave_sum(float v) {
    v += pg8::xshfl<1>(v); v += pg8::xshfl<2>(v); v += pg8::xshfl<4>(v); v += pg8::xshfl<8>(v); v += pg8::xshfl<16>(v); v += pg8::xshfl<32>(v);
    return v;
}
__device__ __forceinline__ float gelu_erf(float x) { return 0.5f * x * (1.0f + erff(x * 0.70710678118654752f)); }
__device__ __forceinline__ float sigmoidf_(float x) { return 1.0f / (1.0f + __expf(-x)); }

__device__ __forceinline__ int lane_now() { int l; asm volatile("v_mbcnt_lo_u32_b32 %0, -1, 0\n\tv_mbcnt_hi_u32_b32 %0, -1, %0" : "=v"(l)); return l; }
#define XB_TMO      128
#define XB_XCNT(j)  (256  + 64 * (j))
#define XB_XSUB(j)  (1280 + 64 * (j))
#define XB_XGEN(j)  (2304 + 64 * (j))
#define XB_TOP      3328
#define XB_TOPGEN   3392
#define XCD_BAR_WORDS 3456
#define XB_SPIN_CAP (1u << 18)

__device__ __forceinline__ unsigned xb_ld(unsigned* p)              { return __hip_atomic_load(p, __ATOMIC_RELAXED, __HIP_MEMORY_SCOPE_AGENT); }
__device__ __forceinline__ unsigned xb_add(unsigned* p, unsigned v) { return __hip_atomic_fetch_add(p, v, __ATOMIC_RELAXED, __HIP_MEMORY_SCOPE_AGENT); }
__device__ __forceinline__ unsigned xb_xcc_id() { return (unsigned)__builtin_amdgcn_s_getreg((3 << 11) | 20) & 0xFu; }
#define XB_SPIN(cond, bar) do { unsigned _sp = 0; while (cond) { __builtin_amdgcn_s_sleep(1); \
    if ((++_sp & 255u) == 0u) { if (xb_ld(&(bar)[XB_TMO])) break; if (_sp > XB_SPIN_CAP) { atomicAdd(&(bar)[XB_TMO], 1u); break; } } } } while (0)

struct XcdBarrier {
    unsigned* bar; unsigned x;
    volatile LAS unsigned* st;
};

__device__ __forceinline__ XcdBarrier xcd_barrier_post(unsigned* bar, volatile LAS unsigned* st) {
    XcdBarrier b; b.bar = bar; b.x = xb_xcc_id(); b.st = st;
    if (threadIdx.x == 0) (void)xb_add(&bar[XB_XCNT(b.x)], 1u);
    return b;
}
__device__ __forceinline__ void xcd_barrier_complete(unsigned* bar, unsigned x, unsigned& nloc, unsigned& nx) {
    const unsigned G = gridDim.x * gridDim.y * gridDim.z;
    unsigned sum, cnt, mine, sp = 0u;
    for (;;) {
        sum = 0u; cnt = 0u; mine = 0u;
#pragma unroll
        for (unsigned j = 0; j < 16; ++j) { const unsigned c = xb_ld(&bar[XB_XCNT(j)]); sum += c; cnt += (c > 0u) ? 1u : 0u; mine = (j == x) ? c : mine; }
        if (sum == G) break;
        __builtin_amdgcn_s_sleep(1);
        if ((++sp & 255u) == 0u) { if (xb_ld(&bar[XB_TMO])) break; if (sp > XB_SPIN_CAP) { atomicAdd(&bar[XB_TMO], 1u); break; } }
    }
    nloc = mine > 0u ? mine : 1u; nx = cnt > 0u ? cnt : 1u;
}

__device__ __forceinline__ void xcd_barrier(const XcdBarrier& b, int wv) {
    asm volatile("s_waitcnt vmcnt(0)" ::: "memory");
    __syncthreads();
    if (wv == 0 && lane_now() == 0) {
        unsigned* bar = b.bar; asm volatile("" : "+s"(bar));
        __builtin_amdgcn_s_waitcnt(0);
        const unsigned bx = xb_xcc_id();
        unsigned nloc = b.st[0], nx = b.st[1];
        if (nloc == 0u) { xcd_barrier_complete(bar, bx, nloc, nx); b.st[0] = nloc; b.st[1] = nx; }
        const unsigned old = xb_add(&bar[XB_XSUB(bx)], 1u);
        const unsigned gen = old / nloc;
        if (old + 1u == (gen + 1u) * nloc) {
            __builtin_amdgcn_fence(__ATOMIC_RELEASE, "agent");
            asm volatile("s_waitcnt vmcnt(0)" ::: "memory");
            const unsigned og = xb_add(&bar[XB_TOP], 1u);
            const unsigned tg = og / nx;
            if (og + 1u == (tg + 1u) * nx) xb_add(&bar[XB_TOPGEN], 1u);
            else XB_SPIN(xb_ld(&bar[XB_TOPGEN]) == tg, bar);
            __builtin_amdgcn_fence(__ATOMIC_ACQUIRE, "agent");
            asm volatile("s_waitcnt vmcnt(0)" ::: "memory");
        } else {
            XB_SPIN(xb_ld(&bar[XB_TOPGEN]) == gen, bar);
            __builtin_amdgcn_fence(__ATOMIC_ACQUIRE, "agent");
            asm volatile("s_waitcnt vmcnt(0)" ::: "memory");
        }
    }
    __syncthreads();
}


struct Ctx { int tid, lane, wave, gw, ngw; LAS unsigned char* lds; };
__device__ __forceinline__ Ctx make_ctx(LAS unsigned char* lds, int wv) { asm volatile("" : "+s"(wv)); int t = wv * 64 + lane_now(); asm volatile("" : "+v"(t));
    Ctx cx; cx.tid = t; cx.lane = t & 63; cx.wave = __builtin_amdgcn_readfirstlane(t >> 6); cx.gw = blockIdx.x * NWAVES + cx.wave; cx.ngw = gridDim.x * NWAVES; cx.lds = lds; return cx; }

template <int MODE>
__device__ __forceinline__ void transpose_item(const float* W, int K, int N, bf16* WT, LAS float* scr, int item, int lane) {
    const int nblk = N / 32, kb = item / nblk, nb = item % nblk, k0 = 64 * kb, n0 = 32 * nb;
    int d0 = n0;
    if (MODE == 1) d0 = ((n0 & 1023) >> 7) * 256 + (n0 >> 10) * 128 + (n0 & 127);
    if (MODE == 2) { const int s = n0 >> 10, c = n0 & 1023, t = c >> 7, o = c & 127;
        d0 = s == 0 ? t * 256 + o : s == 2 ? t * 256 + 128 + o : s == 1 ? (8 + t) * 256 + o : s == 5 ? (8 + t) * 256 + 128 + o : s == 3 ? (16 + t) * 256 + o : s == 6 ? (16 + t) * 256 + 128 + o : 24 * 256 + c; }
#pragma unroll 8
    for (int i = 0; i < 32; ++i) { const int kk = 2 * i + (lane >> 5); scr[kk * 33 + (lane & 31)] = W[(size_t)(k0 + kk) * N + n0 + (lane & 31)]; }
    asm volatile("s_waitcnt lgkmcnt(0)" ::: "memory");
    const int c = lane & 7;
#pragma unroll
    for (int j = 0; j < 4; ++j) { const int n = (lane >> 3) + 8 * j; const LAS float* s = scr + (8 * c) * 33 + n;
        if (MODE == 1 || MODE == 3) { u32x2 o; o.x = 0u; o.y = 0u;
            o.x = __builtin_amdgcn_cvt_pk_fp8_f32(s[0 * 33] * WSCALE, s[1 * 33] * WSCALE, o.x, false); o.x = __builtin_amdgcn_cvt_pk_fp8_f32(s[2 * 33] * WSCALE, s[3 * 33] * WSCALE, o.x, true);
            o.y = __builtin_amdgcn_cvt_pk_fp8_f32(s[4 * 33] * WSCALE, s[5 * 33] * WSCALE, o.y, false); o.y = __builtin_amdgcn_cvt_pk_fp8_f32(s[6 * 33] * WSCALE, s[7 * 33] * WSCALE, o.y, true);
            *(u32x2*)((unsigned char*)WT + (size_t)(d0 + n) * K + k0 + 8 * c) = o; }
        else { u32x4 o; o.x = pk2(s[0 * 33], s[1 * 33]); o.y = pk2(s[2 * 33], s[3 * 33]); o.z = pk2(s[4 * 33], s[5 * 33]); o.w = pk2(s[6 * 33], s[7 * 33]);
            *(u32x4*)(WT + (size_t)(d0 + n) * K + k0 + 8 * c) = o; } }
    asm volatile("s_waitcnt lgkmcnt(0)" ::: "memory");
}

__device__ __forceinline__ void win_block_item(const float* W, signed char* WQ, float* wsc, LAS unsigned char* lds, int item, int wave, int lane, int tid) {
    const int n0 = 32 * item, s = n0 >> 10, c = n0 & 1023, t = c >> 7, o = c & 127;
    const int d0 = s == 0 ? t * 256 + o : s == 2 ? t * 256 + 128 + o : s == 1 ? (8 + t) * 256 + o : s == 5 ? (8 + t) * 256 + 128 + o : s == 3 ? (16 + t) * 256 + o : s == 6 ? (16 + t) * 256 + 128 + o : 24 * 256 + c;
    LAS float* scr = (LAS float*)(lds + wave * 16384);
    LAS float* wmax = (LAS float*)(lds + 8 * 16384);
    LAS float* invs = wmax + 256;
    float v[64]; float mx = 0.f;
    { const float* wp = W + (size_t)(128 * wave + (lane >> 5)) * DIN + n0 + (lane & 31);
#pragma unroll
      for (int i = 0; i < 64; ++i) v[i] = wp[(size_t)(2 * i) * DIN];
#pragma unroll
      for (int i = 0; i < 64; ++i) mx = fmaxf(mx, fabsf(v[i])); }
    mx = fmaxf(mx, pg8::xshfl<32>(mx));
    if (lane < 32) wmax[wave * 32 + lane] = mx;
    __syncthreads();
    if (tid < 32) { float m = wmax[tid];
#pragma unroll
        for (int w = 1; w < 8; ++w) m = fmaxf(m, wmax[w * 32 + tid]);
        invs[tid] = m > 0.f ? 127.0f / m : 0.f; wsc[d0 + tid] = m > 0.f ? m * (1.0f / 127.0f) : 1.0f; }
    __syncthreads();
#pragma unroll
    for (int kb2 = 0; kb2 < 2; ++kb2) {
        const int kb = 2 * wave + kb2;
#pragma unroll
        for (int i = 0; i < 32; ++i) { const int kk = 2 * i + (lane >> 5); scr[kk * 33 + (lane & 31)] = v[32 * kb2 + i]; }
        asm volatile("s_waitcnt lgkmcnt(0)" ::: "memory");
        const int cc = lane & 7;
#pragma unroll
        for (int j = 0; j < 4; ++j) { const int n = (lane >> 3) + 8 * j; const LAS float* sp = scr + (8 * cc) * 33 + n; const float iv = invs[n]; int q[8];
#pragma unroll
            for (int e = 0; e < 8; ++e) q[e] = (int)__builtin_rintf(sp[e * 33] * iv) & 0xff;
            u32x2 w; w.x = (unsigned)q[0] | ((unsigned)q[1] << 8) | ((unsigned)q[2] << 16) | ((unsigned)q[3] << 24); w.y = (unsigned)q[4] | ((unsigned)q[5] << 8) | ((unsigned)q[6] << 16) | ((unsigned)q[7] << 24);
            *(u32x2*)(WQ + (size_t)(d0 + n) * D + 64 * kb + 8 * cc) = w; }
        asm volatile("s_waitcnt lgkmcnt(0)" ::: "memory");
    }
    __syncthreads();
}

__device__ __forceinline__ void phase_prologue(const P& p, LAS unsigned char* lds_, int wv_) {
    const Ctx cx = make_ctx(lds_, wv_);
    const bool rev = (blockIdx.x & 1) != 0;
    for (int step = 0; step < 3; ++step) {
    const int part = rev ? 2 - step : step;
    if (part == 0) {
    {
        const float* c = p.in[1]; const float* w_ada = p.in[2]; const float* b_ada = p.in[3];
        float* mod = (float*)(p.ws + WS_MOD);
        LAS float* red = (LAS float*)cx.lds;
        LAS float* sl = (LAS float*)(cx.lds + 8192);
        if (blockIdx.x < NL * 48) { for (int i = cx.tid; i < 2 * D; i += NTHREADS) { const float cv = c[i]; sl[i] = cv / (1.0f + expf(-cv)); } }
        __syncthreads();
        const int h = cx.lane >> 5, li = cx.lane & 31;
        for (int item = blockIdx.x; item < NL * 48; item += gridDim.x) {
            const int l = item / 48, col0 = (item % 48) * 128;
            f32x4 a0 = (f32x4){0.f, 0.f, 0.f, 0.f}, a1 = a0;
            const float* wp = w_ada + ((size_t)l * D + cx.wave * 128) * 6144 + col0 + 4 * li;
#pragma unroll 32
            for (int i = 0; i < 64; ++i) {
                const int kk = 2 * i + h, k = cx.wave * 128 + kk;
                const float s0 = sl[k], s1 = sl[D + k];
                const f32x4 wv = *(const f32x4*)(wp + (size_t)kk * 6144);
                a0 += wv * s0; a1 += wv * s1;
            }
#pragma unroll
            for (int j = 0; j < 4; ++j) { a0[j] += pg8::xshfl<32>(a0[j]); a1[j] += pg8::xshfl<32>(a1[j]); }
            if (h == 0) { *(LAS f32x4*)(red + (cx.wave * 2 + 0) * 128 + 4 * li) = a0; *(LAS f32x4*)(red + (cx.wave * 2 + 1) * 128 + 4 * li) = a1; }
            __syncthreads();
            if (cx.tid < 256) { const int b = cx.tid >> 7, col = cx.tid & 127; float s = b_ada[l * 6144 + col0 + col];
#pragma unroll
                for (int w = 0; w < 8; ++w) s += red[(w * 2 + b) * 128 + col];
                mod[(size_t)(l * 2 + b) * 6144 + col0 + col] = s; }
            __syncthreads();
        }
    }
    {
        const float* rw = p.in[12]; bf16* RTH = (bf16*)(p.ws + WS_RTH); bf16* RTL = (bf16*)(p.ws + WS_RTL);
        for (int idx = blockIdx.x * NTHREADS + cx.tid; idx < NL * NE * D; idx += gridDim.x * NTHREADS) {
            const int l = idx / (NE * D), r = idx % (NE * D), e = r / D, k = r % D;
            const float w = rw[((size_t)l * D + k) * NE + e]; const unsigned hi = f2bf(w);
            RTH[idx] = (bf16)hi; RTL[idx] = (bf16)f2bf(w - __builtin_bit_cast(float, hi << 16));
        }
    }
    {
        const float* ws = p.in[7]; bf16* WSB = (bf16*)(p.ws + WS_WSB);
        for (int idx = blockIdx.x * NTHREADS + cx.tid; idx < NL * NG * CHK * CHK; idx += gridDim.x * NTHREADS) { const int s = idx & 127, t = (idx >> 7) & 127; WSB[idx] = (bf16)f2bf(s <= t ? ws[idx] : 0.f); }
    }
    }
    if (part == 1) {
    for (int item = blockIdx.x; item < NL * 224; item += gridDim.x) { const int mi = item / 224;
        win_block_item(p.in[5] + (size_t)mi * D * DIN, (signed char*)(p.ws + WS_WIN) + (size_t)mi * DIN * D, (float*)(p.ws + WS_WSC) + (size_t)mi * DIN, cx.lds, item % 224, cx.wave, cx.lane, cx.tid); }
    }
    if (part == 2) {
    {
        LAS float* scr = (LAS float*)(cx.lds + cx.wave * 16384);
        constexpr int I_GU = 16 * 64, I_DN = 16 * 32, I_IN = 224  , I_OUT = 16 * 32;
        const int N_GU = gridDim.x == 256 ? 0 : NL * NE * I_GU, N_DN = gridDim.x == 256 ? 0 : NL * NE * I_DN; constexpr int N_OUT = NL * I_OUT;
        const int NITEMS = N_GU + N_DN + N_OUT;
        for (int it = cx.gw; it < NITEMS; it += cx.ngw) {
            int r = it;
            if (r < N_GU) { const int mi = r / I_GU; transpose_item<1>(p.in[14] + (size_t)mi * D * 2 * DFF, D, 2 * DFF, (bf16*)(p.ws + WS_WGU + (size_t)mi * 2 * DFF * D), scr, r % I_GU, cx.lane); continue; } r -= N_GU;
            if (r < N_DN) { const int mi = r / I_DN; transpose_item<3>(p.in[16] + (size_t)mi * DFF * D, DFF, D, (bf16*)(p.ws + WS_WDN + (size_t)mi * D * DFF), scr, r % I_DN, cx.lane); continue; } r -= N_DN;
            { const int mi = r / I_OUT; transpose_item<3>(p.in[10] + (size_t)mi * D * D, D, D, (bf16*)(p.ws + WS_WOUT + (size_t)mi * D * D), scr, r % I_OUT, cx.lane); }
        }
    }
    }
    __syncthreads();
    }
}

template <int MODE>
__device__ __forceinline__ void phase_norm1(const P& p, LAS unsigned char* lds_, int wv_, int l) {
    const Ctx cx = make_ctx(lds_, wv_);
    const float* mod = (const float*)(p.ws + WS_MOD);
    bf16* xres = (bf16*)(p.ws + WS_XRES);
    bf16* H = (bf16*)(p.ws + WS_H);
    const unsigned char* Y = p.ws + WS_Y;
    const int* arow = (const int*)(p.ws + WS_AROW); const float* aw = (const float*)(p.ws + WS_AW);
    LAS float* gL = (LAS float*)cx.lds;
    LAS float* shL = gL + D;
    LAS float* scL = shL + 2 * D;
    LAS float* gfL = scL + 2 * D;
    for (int i = cx.tid; i < D / 4; i += NTHREADS) {
        ((LAS f32x4*)gL)[i] = (MODE == 2) ? ((const f32x4*)p.in[18])[i] : ((const f32x4*)(p.in[4] + (size_t)l * D))[i];
#pragma unroll
        for (int b = 0; b < 2; ++b) {
            if (MODE != 2) { ((LAS f32x4*)(shL + b * D))[i] = ((const f32x4*)(mod + (size_t)(l * 2 + b) * 6144 + 0 * D))[i]; ((LAS f32x4*)(scL + b * D))[i] = ((const f32x4*)(mod + (size_t)(l * 2 + b) * 6144 + 1 * D))[i] + 1.0f; }
            if (MODE != 0) ((LAS f32x4*)(gfL + b * D))[i] = ((const f32x4*)(mod + (size_t)((l - 1) * 2 + b) * 6144 + 5 * D))[i];
        }
    }
    __syncthreads();
    const int step = 2 * cx.ngw;
    int arN[2][TOPK]; float awN[2][TOPK]; float awC[2][TOPK]; unsigned qC[2][TOPK][4]; u32x2 xC[2][4];
#define N1_IDX(ROW0_, AR_, AW_) do { _Pragma("unroll") for (int u_ = 0; u_ < 2; ++u_) _Pragma("unroll") for (int k_ = 0; k_ < TOPK; ++k_) { AR_[u_][k_] = arow[((ROW0_) + u_ * cx.ngw) * 4 + k_]; AW_[u_][k_] = aw[((ROW0_) + u_ * cx.ngw) * 4 + k_]; } } while (0)
#define N1_LOAD(ROW0_, AR_, Q_, X_) do { _Pragma("unroll") for (int u_ = 0; u_ < 2; ++u_) { const u32x2* xr_ = (const u32x2*)(xres + (size_t)((ROW0_) + u_ * cx.ngw) * D) + cx.lane; \
        _Pragma("unroll") for (int j_ = 0; j_ < 4; ++j_) X_[u_][j_] = xr_[64 * j_]; \
        _Pragma("unroll") for (int k_ = 0; k_ < TOPK; ++k_) { const unsigned* yr_ = (const unsigned*)(Y + (size_t)AR_[u_][k_] * D) + cx.lane; _Pragma("unroll") for (int j_ = 0; j_ < 4; ++j_) Q_[u_][k_][j_] = yr_[64 * j_]; } } } while (0)
    if (MODE != 0) { int ar0[2][TOPK]; N1_IDX(cx.gw, ar0, awC); N1_LOAD(cx.gw, ar0, qC, xC); if (cx.gw + step < T) N1_IDX(cx.gw + step, arN, awN); }
    for (int row0 = cx.gw; row0 < T; row0 += step) {
        f32x4 v[2][4]; int rr[2];
#pragma unroll
        for (int u = 0; u < 2; ++u) rr[u] = row0 + u * cx.ngw;
        if (MODE == 0) {
#pragma unroll
            for (int u = 0; u < 2; ++u) { const f32x4* xr = (const f32x4*)(p.in[0] + (size_t)rr[u] * D) + cx.lane;
#pragma unroll
                for (int j = 0; j < 4; ++j) v[u][j] = xr[64 * j]; }
        } else {
            unsigned qX[2][TOPK][4]; u32x2 xX[2][4]; int arX[2][TOPK]; float awX[2][TOPK];
            const bool h1 = row0 + step < T, h2 = row0 + 2 * step < T;
            if (h1) N1_LOAD(row0 + step, arN, qX, xX);
            if (h2) N1_IDX(row0 + 2 * step, arX, awX);
#pragma unroll
            for (int u = 0; u < 2; ++u) {
                const int b = rr[u] / SEQ;
                const LAS f32x4* gf = (const LAS f32x4*)(gfL + b * D) + cx.lane;
                u32x2* xw = (u32x2*)(xres + (size_t)rr[u] * D) + cx.lane;
#pragma unroll
                for (int j = 0; j < 4; ++j) { const u32x2 xq = xC[u][j]; v[u][j] = (f32x4){bflo(xq.x), bfhi(xq.x), bflo(xq.y), bfhi(xq.y)};
                    f32x4 acc = (f32x4){0.f, 0.f, 0.f, 0.f};
#pragma unroll
                    for (int k = 0; k < TOPK; ++k) { const auto lo = __builtin_amdgcn_cvt_pk_f32_fp8(qC[u][k][j], false), hi = __builtin_amdgcn_cvt_pk_f32_fp8(qC[u][k][j], true); acc += (f32x4){lo[0], lo[1], hi[0], hi[1]} * (awC[u][k] * (1.0f / YSCALE)); }
                    v[u][j] += gf[64 * j] * acc; if (MODE == 1) { u32x2 w; w.x = pk2(v[u][j].x, v[u][j].y); w.y = pk2(v[u][j].z, v[u][j].w); xw[64 * j] = w; } }
            }
#pragma unroll
            for (int u = 0; u < 2; ++u) {
#pragma unroll
                for (int k = 0; k < TOPK; ++k) { awC[u][k] = awN[u][k]; if (h2) { awN[u][k] = awX[u][k]; arN[u][k] = arX[u][k]; }
#pragma unroll
                    for (int j = 0; j < 4; ++j) if (h1) qC[u][k][j] = qX[u][k][j]; }
#pragma unroll
                for (int j = 0; j < 4; ++j) if (h1) xC[u][j] = xX[u][j]; }
        }
#pragma unroll
        for (int u = 0; u < 2; ++u) {
            const int row = rr[u], b = row / SEQ;
            float ss = 0.f;
#pragma unroll
            for (int j = 0; j < 4; ++j) ss += (v[u][j].x * v[u][j].x + v[u][j].y * v[u][j].y) + (v[u][j].z * v[u][j].z + v[u][j].w * v[u][j].w);
            const float rstd = 1.0f / sqrtf(wave_sum(ss) * (1.0f / D) + EPS);
            const LAS f32x4* g = (const LAS f32x4*)gL + cx.lane;
            if (MODE == 2) {
                f32x4* o = (f32x4*)(p.out + (size_t)row * D) + cx.lane;
#pragma unroll
                for (int j = 0; j < 4; ++j) o[64 * j] = v[u][j] * rstd * g[64 * j];
            } else {
                const LAS f32x4* sh = (const LAS f32x4*)(shL + b * D) + cx.lane;
                const LAS f32x4* sc = (const LAS f32x4*)(scL + b * D) + cx.lane;
                f32x4 hh[4]; float am = 0.f;
#pragma unroll
                for (int j = 0; j < 4; ++j) { hh[j] = v[u][j] * rstd * g[64 * j] * sc[64 * j] + sh[64 * j]; am = fmaxf(fmaxf(am, fmaxf(fabsf(hh[j].x), fabsf(hh[j].y))), fmaxf(fabsf(hh[j].z), fabsf(hh[j].w))); }
                am = fmaxf(am, pg8::xshfl<1>(am)); am = fmaxf(am, pg8::xshfl<2>(am)); am = fmaxf(am, pg8::xshfl<4>(am)); am = fmaxf(am, pg8::xshfl<8>(am)); am = fmaxf(am, pg8::xshfl<16>(am)); am = fmaxf(am, pg8::xshfl<32>(am));
                const float inv = am > 0.f ? 127.0f / am : 0.f;
                unsigned* o = (unsigned*)((signed char*)H + (size_t)row * D) + cx.lane;
#pragma unroll
                for (int j = 0; j < 4; ++j) { const int q0 = (int)__builtin_rintf(hh[j].x * inv) & 0xff, q1 = (int)__builtin_rintf(hh[j].y * inv) & 0xff, q2 = (int)__builtin_rintf(hh[j].z * inv) & 0xff, q3 = (int)__builtin_rintf(hh[j].w * inv) & 0xff;
                    o[64 * j] = (unsigned)q0 | ((unsigned)q1 << 8) | ((unsigned)q2 << 16) | ((unsigned)q3 << 24); }
                if (cx.lane == 0) ((float*)(p.ws + WS_HS))[row] = am > 0.f ? am * (1.0f / 127.0f) : 1.0f;
            }
        }
    }
}

#undef N1_IDX
#undef N1_LOAD
typedef short bf16x8_m __attribute__((ext_vector_type(8)));
__device__ __forceinline__ void unpack8(const u32x4 w, float (&f)[8]) {
#pragma unroll
    for (int j = 0; j < 4; ++j) { f[2 * j] = bflo(w[j]); f[2 * j + 1] = bfhi(w[j]); } }
__device__ __forceinline__ void phase_mixer(const P& p, LAS unsigned char* lds_, int wv_, int l) {
    const Ctx cx = make_ctx(lds_, wv_);
    const bf16* PB = (const bf16*)(p.ws + WS_Z); const bf16* QA = PB + (size_t)T * D; const bf16* GU = QA + (size_t)T * D; const unsigned char* GV8 = (const unsigned char*)(GU + (size_t)T * D);
    unsigned char* M8 = p.ws + WS_M;
    const float* vst = (const float*)(p.ws + WS_VST);
    const bf16* WSB = (const bf16*)(p.ws + WS_WSB) + (size_t)l * NG * CHK * CHK;
    const float* conv_w = p.in[6] + (size_t)l * 3 * D; const float* b_s = p.in[8] + (size_t)l * NG * CHK; const float* ln_g = p.in[9] + (size_t)l * D;
    constexpr int RS = 272;
    LAS unsigned char* WmL = cx.lds;
    LAS unsigned char* VT = cx.lds + 128 * RS;
    LAS float* SL = (LAS float*)(cx.lds + 2 * 128 * RS);
    LAS float* st = (LAS float*)(cx.lds + 2 * 128 * RS + 128 * 132 * 4);
    LAS float* lngL = st + 256;
    LAS float* cwL = lngL + D;
    LAS float* bsL = cwL + 3 * D;
    for (int i = cx.tid; i < D / 4; i += NTHREADS) { ((LAS f32x4*)lngL)[i] = ((const f32x4*)ln_g)[i]; ((LAS f32x4*)bsL)[i] = ((const f32x4*)b_s)[i]; }
    for (int i = cx.tid; i < 3 * D / 4; i += NTHREADS) ((LAS f32x4*)cwL)[i] = ((const f32x4*)conv_w)[i];
    for (int chunk = blockIdx.x; chunk < NCHUNK; chunk += gridDim.x) {
        const int tok0 = chunk * CHK;
        if (cx.tid < CHK) { const f32x4* sp = (const f32x4*)(vst + (size_t)(tok0 + cx.tid) * 32); float s = 0.f, q = 0.f;
#pragma unroll
            for (int j = 0; j < 8; ++j) { const f32x4 t4 = sp[j]; s += t4.x + t4.z; q += t4.y + t4.w; }
            const float mean = s * (1.0f / D), var = fmaxf(q * (1.0f / D) - mean * mean, 0.f);
            st[cx.tid] = mean * GVSCALE; st[128 + cx.tid] = (1.0f / GVSCALE) / sqrtf(var + EPS); }
        __syncthreads();
        u32x4 wq[4]; u32x2 vq[4];
#pragma unroll
        for (int i = 0; i < 4; ++i) { const int idx = cx.tid + NTHREADS * i; wq[i] = *(const u32x4*)(WSB + idx * 8);
            const int s = idx & 127, c8 = idx >> 7; vq[i] = *(const u32x2*)(GV8 + (size_t)(tok0 + s) * D + c8 * 8); }
#define MIX_LOAD(G_, I_) do { const int idx_ = cx.tid + NTHREADS * (I_), t_ = idx_ >> 4, c8_ = idx_ & 15, tok_ = tok0 + t_, tseq_ = tok_ & (SEQ - 1); const size_t off_ = (size_t)tok_ * D + (G_) * CHK + c8_ * 8; \
            eg[I_] = *(const u32x4*)(GU + off_); eq[I_] = *(const u32x4*)(QA + off_); e0[I_] = *(const u32x4*)(PB + off_); \
            e1[I_] = tseq_ >= 1 ? *(const u32x4*)(PB + off_ - D) : (u32x4){0u, 0u, 0u, 0u}; e2[I_] = tseq_ >= 2 ? *(const u32x4*)(PB + off_ - 2 * D) : (u32x4){0u, 0u, 0u, 0u}; } while (0)
        u32x4 eg[4], eq[4], e0[4], e1[4], e2[4];
#pragma unroll
        for (int i = 0; i < 4; ++i) MIX_LOAD(0, i);
        for (int g = 0; g < NG; ++g) {
#pragma unroll
            for (int i = 0; i < 4; ++i) { const int idx = cx.tid + NTHREADS * i; *(LAS u32x4*)(WmL + (idx >> 4) * RS + (idx & 15) * 16) = wq[i]; }
#pragma unroll
            for (int i = 0; i < 4; ++i) { const int idx = cx.tid + NTHREADS * i, s = idx & 127, c8 = idx >> 7; float f[8]; { const auto a0 = __builtin_amdgcn_cvt_pk_f32_fp8(vq[i].x, false), a1 = __builtin_amdgcn_cvt_pk_f32_fp8(vq[i].x, true), a2 = __builtin_amdgcn_cvt_pk_f32_fp8(vq[i].y, false), a3 = __builtin_amdgcn_cvt_pk_f32_fp8(vq[i].y, true); f[0] = a0[0]; f[1] = a0[1]; f[2] = a1[0]; f[3] = a1[1]; f[4] = a2[0]; f[5] = a2[1]; f[6] = a3[0]; f[7] = a3[1]; }
                const float mu = st[s], rs = st[128 + s]; const f32x4 l0 = *(const LAS f32x4*)(lngL + g * CHK + c8 * 8), l1 = *(const LAS f32x4*)(lngL + g * CHK + c8 * 8 + 4);
                const float lg[8] = {l0.x, l0.y, l0.z, l0.w, l1.x, l1.y, l1.z, l1.w};
#pragma unroll
                for (int j = 0; j < 8; j += 2) { const unsigned w2 = pk2((f[j] - mu) * rs * lg[j], (f[j + 1] - mu) * rs * lg[j + 1]);
                    *(LAS unsigned short*)(VT + (c8 * 8 + j) * RS + s * 2) = (unsigned short)(w2 & 0xffffu); *(LAS unsigned short*)(VT + (c8 * 8 + j + 1) * RS + s * 2) = (unsigned short)(w2 >> 16); } }
            if (g + 1 < NG) {
#pragma unroll
                for (int i = 0; i < 4; ++i) { const int idx = cx.tid + NTHREADS * i; wq[i] = *(const u32x4*)(WSB + (size_t)(g + 1) * CHK * CHK + idx * 8);
                    const int s = idx & 127, c8 = idx >> 7; vq[i] = *(const u32x2*)(GV8 + (size_t)(tok0 + s) * D + (g + 1) * CHK + c8 * 8); }
            }
            __syncthreads();
            { const int fr = cx.lane & 15, fq = cx.lane >> 4, pp = cx.wave >> 1, hh = cx.wave & 1;
#pragma unroll
              for (int rbi = 0; rbi < 2; ++rbi) { const int rb = rbi ? 7 - pp : pp, nks = (rb >> 1) + 1; f32x4 acc[4];
#pragma unroll
                for (int nt = 0; nt < 4; ++nt) acc[nt] = (f32x4){0.f, 0.f, 0.f, 0.f};
                for (int ks = 0; ks < nks; ++ks) {
                    const bf16x8_m A = *(const LAS bf16x8_m*)(WmL + (rb * 16 + fr) * RS + (32 * ks + 8 * fq) * 2);
#pragma unroll
                    for (int nt = 0; nt < 4; ++nt) { const bf16x8_m B = *(const LAS bf16x8_m*)(VT + ((4 * hh + nt) * 16 + fr) * RS + (32 * ks + 8 * fq) * 2); acc[nt] = __builtin_amdgcn_mfma_f32_16x16x32_bf16(A, B, acc[nt], 0, 0, 0); }
                }
#pragma unroll
                for (int nt = 0; nt < 4; ++nt)
#pragma unroll
                    for (int r = 0; r < 4; ++r) SL[(rb * 16 + 4 * fq + r) * 132 + (4 * hh + nt) * 16 + fr] = acc[nt][r];
              }
            }
            __syncthreads();
#pragma unroll
            for (int i = 0; i < 4; ++i) { const int idx = cx.tid + NTHREADS * i, t = idx >> 4, c8 = idx & 15, tok = tok0 + t, ch0 = g * CHK + c8 * 8;
                const f32x4 s0 = *(const LAS f32x4*)(SL + t * 132 + c8 * 8), s1 = *(const LAS f32x4*)(SL + t * 132 + c8 * 8 + 4); const float sv[8] = {s0.x, s0.y, s0.z, s0.w, s1.x, s1.y, s1.z, s1.w};
                const float bs = bsL[g * CHK + t];
                float fg[8], fqa[8], f0[8], f1[8], f2[8]; unpack8(eg[i], fg); unpack8(eq[i], fqa); unpack8(e0[i], f0); unpack8(e1[i], f1); unpack8(e2[i], f2);
                float c0[8], c1[8], c2[8];
#pragma unroll
                for (int h = 0; h < 2; ++h) { const f32x4 a = *(const LAS f32x4*)(cwL + ch0 + 4 * h), bq = *(const LAS f32x4*)(cwL + D + ch0 + 4 * h), c = *(const LAS f32x4*)(cwL + 2 * D + ch0 + 4 * h);
#pragma unroll
                    for (int j = 0; j < 4; ++j) { c0[4 * h + j] = a[j]; c1[4 * h + j] = bq[j]; c2[4 * h + j] = c[j]; } }
                float o[8];
#pragma unroll
                for (int j = 0; j < 8; ++j) o[j] = fqa[j] * (c0[j] * f2[j] + c1[j] * f1[j] + c2[j] * f0[j]) + fg[j] * (sv[j] + bs);
#pragma unroll
                for (int j = 0; j < 8; ++j) o[j] = fminf(fmaxf(o[j] * MSCALE, -448.0f), 448.0f);
                u32x2 w; w.x = 0u; w.y = 0u;
                w.x = __builtin_amdgcn_cvt_pk_fp8_f32(o[0], o[1], w.x, false); w.x = __builtin_amdgcn_cvt_pk_fp8_f32(o[2], o[3], w.x, true); w.y = __builtin_amdgcn_cvt_pk_fp8_f32(o[4], o[5], w.y, false); w.y = __builtin_amdgcn_cvt_pk_fp8_f32(o[6], o[7], w.y, true);
                *(u32x2*)(M8 + (size_t)tok * D + ch0) = w;
                if (g + 1 < NG) MIX_LOAD(g + 1, i); }
        }
#undef MIX_LOAD
        __syncthreads();
    }
}

constexpr int CW_BAR = 4096;
constexpr int CW_RS = 16384;
typedef short bf16x8_t __attribute__((ext_vector_type(8)));
constexpr int RT_STRIDE = 2064;
__device__ __forceinline__ void phase_router(const P& p, LAS unsigned char* lds_, int wv_, int l) {
    const Ctx cx = make_ctx(lds_, wv_);
    const float* mod = (const float*)(p.ws + WS_MOD); const bf16* xres = (const bf16*)(p.ws + WS_XRES); unsigned char* H8 = p.ws + WS_H8;
    const bf16* RTH = (const bf16*)(p.ws + WS_RTH) + (size_t)l * NE * D; const bf16* RTL = (const bf16*)(p.ws + WS_RTL) + (size_t)l * NE * D; const float* rb = p.in[13] + l * NE;
    const float* ssq = (const float*)(p.ws + WS_SSQ);
    int* cnt = (int*)(p.ws + WS_CNT); int* ae = (int*)(p.ws + WS_AE); int* ar = (int*)(p.ws + WS_AR); float* aw = (float*)(p.ws + WS_AW);
    LAS unsigned char* RH = cx.lds; LAS unsigned char* RL = cx.lds + 66048;
    LAS float* gsl = (LAS float*)(cx.lds + 132096); LAS float* shl = gsl + D;
    LAS int* wcnt = (LAS int*)(cx.lds + 140288);
    LAS int* wbase = wcnt + 256;
    LAS int* la_e = wbase + 256;
    LAS int* la_r = la_e + 512;
    const bool fused = gridDim.x == NCHUNK;
    for (int chunk = blockIdx.x; chunk < NCHUNK; chunk += gridDim.x) {
        const int b = (chunk * CHK) / SEQ;
        const int fr = cx.lane & 15, q = cx.lane >> 4, row = chunk * CHK + cx.wave * 16 + fr;
        const bf16* xr = xres + (size_t)row * D + 8 * q; unsigned char* hr = H8 + (size_t)row * D + 8 * q;
        f32x4 sq4[4];
        { const f32x4* sp = (const f32x4*)(ssq + (size_t)row * 16); sq4[0] = sp[0]; sq4[1] = sp[1]; sq4[2] = sp[2]; sq4[3] = sp[3]; }
        u32x4 xall[D / 32];
#pragma unroll
        for (int ks = 0; ks < D / 32; ++ks) xall[ks] = *(const u32x4*)(xr + 32 * ks);
        for (int idx = cx.tid; idx < NE * (D / 8); idx += NTHREADS) { const int e = idx >> 7, c8 = (idx & 127) * 8;
            *(LAS u32x4*)(RH + e * RT_STRIDE + c8 * 2) = *(const u32x4*)(RTH + (size_t)e * D + c8); *(LAS u32x4*)(RL + e * RT_STRIDE + c8 * 2) = *(const u32x4*)(RTL + (size_t)e * D + c8); }
        if (cx.tid < D / 4) { const f32x4 g = *((const f32x4*)(p.in[11] + (size_t)l * D) + cx.tid), sc = *((const f32x4*)(mod + (size_t)(l * 2 + b) * 6144 + 4 * D) + cx.tid), sh = *((const f32x4*)(mod + (size_t)(l * 2 + b) * 6144 + 3 * D) + cx.tid);
            *((LAS f32x4*)gsl + cx.tid) = g * (sc + 1.0f); *((LAS f32x4*)shl + cx.tid) = sh; }
        __syncthreads();
        float rstd;
        { const f32x4 s0 = sq4[0], s1 = sq4[1], s2 = sq4[2], s3 = sq4[3];
          const float s = ((s0.x + s0.y) + (s0.z + s0.w)) + ((s1.x + s1.y) + (s1.z + s1.w)) + ((s2.x + s2.y) + (s2.z + s2.w)) + ((s3.x + s3.y) + (s3.z + s3.w));
          rstd = 1.0f / sqrtf(s * (1.0f / D) + EPS); }
        f32x4 acc0 = (f32x4){0.f, 0.f, 0.f, 0.f}, acc1 = acc0;
#pragma unroll
        for (int ks = 0; ks < D / 32; ++ks) {
            const u32x4 xq = xall[ks]; const f32x4 x0 = (f32x4){bflo(xq.x), bfhi(xq.x), bflo(xq.y), bfhi(xq.y)}, x1 = (f32x4){bflo(xq.z), bfhi(xq.z), bflo(xq.w), bfhi(xq.w)};
            const f32x4 g0 = *(const LAS f32x4*)(gsl + 32 * ks + 8 * q), g1 = *(const LAS f32x4*)(gsl + 32 * ks + 8 * q + 4), h0 = *(const LAS f32x4*)(shl + 32 * ks + 8 * q), h1 = *(const LAS f32x4*)(shl + 32 * ks + 8 * q + 4);
            const f32x4 a0 = x0 * rstd * g0 + h0, a1 = x1 * rstd * g1 + h1;
            u32x4 hi, lo; float f[8] = {a0.x, a0.y, a0.z, a0.w, a1.x, a1.y, a1.z, a1.w};
#pragma unroll
            for (int j = 0; j < 4; ++j) { const unsigned hw = pk2(f[2 * j], f[2 * j + 1]); hi[j] = hw;
                lo[j] = pk2(f[2 * j] - __builtin_bit_cast(float, hw << 16), f[2 * j + 1] - __builtin_bit_cast(float, hw & 0xffff0000u)); }
            { u32x2 h8; h8.x = 0u; h8.y = 0u; h8.x = __builtin_amdgcn_cvt_pk_fp8_f32(f[0], f[1], h8.x, false); h8.x = __builtin_amdgcn_cvt_pk_fp8_f32(f[2], f[3], h8.x, true);
              h8.y = __builtin_amdgcn_cvt_pk_fp8_f32(f[4], f[5], h8.y, false); h8.y = __builtin_amdgcn_cvt_pk_fp8_f32(f[6], f[7], h8.y, true); *(u32x2*)(hr + 32 * ks) = h8; }
            const bf16x8_t Ah = __builtin_bit_cast(bf16x8_t, hi), Al = __builtin_bit_cast(bf16x8_t, lo);
            const int bo = fr * RT_STRIDE + (32 * ks + 8 * q) * 2;
            const bf16x8_t Bh0 = *(const LAS bf16x8_t*)(RH + bo), Bh1 = *(const LAS bf16x8_t*)(RH + 16 * RT_STRIDE + bo), Bl0 = *(const LAS bf16x8_t*)(RL + bo), Bl1 = *(const LAS bf16x8_t*)(RL + 16 * RT_STRIDE + bo);
            acc0 = __builtin_amdgcn_mfma_f32_16x16x32_bf16(Ah, Bh0, acc0, 0, 0, 0); acc1 = __builtin_amdgcn_mfma_f32_16x16x32_bf16(Ah, Bh1, acc1, 0, 0, 0);
            acc0 = __builtin_amdgcn_mfma_f32_16x16x32_bf16(Ah, Bl0, acc0, 0, 0, 0); acc1 = __builtin_amdgcn_mfma_f32_16x16x32_bf16(Ah, Bl1, acc1, 0, 0, 0);
            acc0 = __builtin_amdgcn_mfma_f32_16x16x32_bf16(Al, Bh0, acc0, 0, 0, 0); acc1 = __builtin_amdgcn_mfma_f32_16x16x32_bf16(Al, Bh1, acc1, 0, 0, 0);
        }
        __syncthreads();
        LAS float* lgw = (LAS float*)(cx.lds + cx.wave * 2048);
        { const float b0 = rb[fr], b1 = rb[16 + fr];
#pragma unroll
          for (int r = 0; r < 4; ++r) { lgw[(4 * q + r) * 32 + fr] = acc0[r] + b0; lgw[(4 * q + r) * 32 + 16 + fr] = acc1[r] + b1; } }
        asm volatile("s_waitcnt lgkmcnt(0)" ::: "memory");
        if (cx.lane < 16) {
            float lg[NE];
#pragma unroll
            for (int j = 0; j < 8; ++j) { const f32x4 t4 = *(const LAS f32x4*)(lgw + cx.lane * 32 + 4 * j); lg[4 * j] = t4.x; lg[4 * j + 1] = t4.y; lg[4 * j + 2] = t4.z; lg[4 * j + 3] = t4.w; }
            int sel[TOPK]; float sv[TOPK]; unsigned taken = 0u;
#pragma unroll
            for (int k = 0; k < TOPK; ++k) { float best = -3.0e38f; int bi = 0;
#pragma unroll
                for (int e = 0; e < NE; ++e) { const bool ok = !((taken >> e) & 1u) && (lg[e] > best); best = ok ? lg[e] : best; bi = ok ? e : bi; }
                sel[k] = bi; sv[k] = best; taken |= 1u << bi; }
            float ex[TOPK], den = 0.f;
#pragma unroll
            for (int k = 0; k < TOPK; ++k) { ex[k] = expf(sv[k] - sv[0]); den += ex[k]; }
            const float inv = 1.0f / den; const int tok = chunk * CHK + cx.wave * 16 + cx.lane;
            *(f32x4*)(aw + (size_t)tok * 4) = (f32x4){ex[0] * inv, ex[1] * inv, ex[2] * inv, ex[3] * inv};
#pragma unroll
            for (int k = 0; k < TOPK; ++k) la_e[cx.wave * 64 + cx.lane * 4 + k] = sel[k];
        }
        asm volatile("s_waitcnt lgkmcnt(0)" ::: "memory");
        {
            const int ea = la_e[cx.wave * 64 + cx.lane]; int rk = 0, ce = 0;
            const unsigned long long below = (1ull << cx.lane) - 1ull;
#pragma unroll 8
            for (int e = 0; e < NE; ++e) { const unsigned long long m = __ballot(ea == e); if (ea == e) rk = __builtin_popcountll(m & below); if (cx.lane == e) ce = __builtin_popcountll(m); }
            la_r[cx.wave * 64 + cx.lane] = rk; if (cx.lane < NE) wcnt[cx.wave * NE + cx.lane] = ce;
        }
        __syncthreads();
        if (cx.tid < NE) { int tot = 0;
#pragma unroll
            for (int w = 0; w < NWAVES; ++w) { wbase[w * NE + cx.tid] = tot; tot += wcnt[w * NE + cx.tid]; }
            if (fused) __hip_atomic_store(&cnt[chunk * NE + cx.tid], tot, __ATOMIC_RELAXED, __HIP_MEMORY_SCOPE_AGENT); else cnt[chunk * NE + cx.tid] = tot; }
        __syncthreads();
        const int e_a = la_e[cx.wave * 64 + cx.lane], r_a = la_r[cx.wave * 64 + cx.lane] + wbase[cx.wave * NE + e_a];
        const int a = (chunk * CHK + cx.wave * 16) * 4 + cx.lane;
        if (!fused) { ae[a] = e_a; ar[a] = r_a; __syncthreads(); continue; }
        asm volatile("s_waitcnt vmcnt(0)" ::: "memory");
        if (cx.tid == 0) { unsigned* bar = (unsigned*)(p.ws + WS_CTL) + CW_BAR; unsigned* ctr = (unsigned*)(p.ws + WS_CTL) + CW_RS + 64 * l; asm volatile("" : "+s"(bar), "+s"(ctr));
            (void)xb_add(ctr, 1u); XB_SPIN(xb_ld(ctr) < (unsigned)NCHUNK, bar); }
        __syncthreads();
        {
            int t2 = cx.wave * 64 + lane_now(); asm volatile("" : "+v"(t2));
            int* arow = (int*)(p.ws + WS_AROW); int* rowtok = (int*)(p.ws + WS_ROWTOK); int* tab = (int*)(p.ws + WS_TAB);
            LAS int* s_tot = (LAS int*)(cx.lds + 32768); LAS int* s_before = s_tot + 32; LAS int* s_pstart = s_tot + 64; LAS int* s_base = s_tot + 96;
            LAS int* part_t = s_tot + 128; LAS int* part_b = part_t + 512;
            { const int e = t2 & 31, pt = t2 >> 5; int tot = 0, bef = 0;
#pragma unroll
              for (int i = 0; i < 16; ++i) { const int c2 = pt * 16 + i; const int v = __hip_atomic_load(&cnt[c2 * NE + e], __ATOMIC_RELAXED, __HIP_MEMORY_SCOPE_AGENT); tot += v; bef += (c2 < chunk) ? v : 0; }
              part_t[pt * 32 + e] = tot; part_b[pt * 32 + e] = bef; }
            __syncthreads();
            if (t2 < NE) { int total = 0, before = 0;
#pragma unroll
                for (int i = 0; i < 16; ++i) { total += part_t[i * 32 + t2]; before += part_b[i * 32 + t2]; }
                s_tot[t2] = total; s_before[t2] = before; }
            __syncthreads();
            if (t2 < NE) { int ps = 0;
#pragma unroll
                for (int e2 = 0; e2 < NE; ++e2) { const int v = (s_tot[e2] + 255) & ~255; ps += (e2 < t2) ? v : 0; }
                s_pstart[t2] = ps; s_base[t2] = ps + s_before[t2]; }
            __syncthreads();
            { const int dest = s_base[e_a] + r_a; rowtok[dest] = a >> 2; arow[a] = dest; }
            if (chunk < NE) { const int e = chunk, lo = s_pstart[e] + s_tot[e], hi = s_pstart[e] + ((s_tot[e] + 255) & ~255); for (int i = lo + t2; i < hi; i += NTHREADS) rowtok[i] = 0; }
            { const int i = (int)blockIdx.x + (int)gridDim.x * t2;
              if (i < NTILE_MAX) { int ee = 0;
#pragma unroll
                  for (int e = 0; e < NE; ++e) if (s_tot[e] > 0 && s_pstart[e] <= i * 256) ee = e;
                  tab[64 + i] = ee; }
              if (chunk == 0 && t2 == 0) tab[0] = (s_pstart[NE - 1] + ((s_tot[NE - 1] + 255) & ~255)) >> 8; }
        }
        __syncthreads();
    }
}

__device__ __forceinline__ void phase_scatter(const P& p, LAS unsigned char* lds_, int wv_) {
    const Ctx cx = make_ctx(lds_, wv_);
    const int* cnt = (const int*)(p.ws + WS_CNT); const int* ae = (const int*)(p.ws + WS_AE); const int* ar = (const int*)(p.ws + WS_AR);
    int* arow = (int*)(p.ws + WS_AROW); int* rowtok = (int*)(p.ws + WS_ROWTOK); int* tab = (int*)(p.ws + WS_TAB);
    LAS int* s_tot = (LAS int*)cx.lds; LAS int* s_before = s_tot + 32; LAS int* s_pstart = s_tot + 64; LAS int* s_base = s_tot + 96;
    LAS int* part_t = s_tot + 128; LAS int* part_b = part_t + 512;
    for (int chunk = blockIdx.x; chunk < NCHUNK; chunk += gridDim.x) {
        const int a = chunk * (CHK * TOPK) + cx.tid; const int ea = ae[a], ra = ar[a];
        { const int e = cx.tid & 31, pt = cx.tid >> 5; int tot = 0, bef = 0;
#pragma unroll
          for (int i = 0; i < 16; ++i) { const int c2 = pt * 16 + i; const int v = cnt[c2 * NE + e]; tot += v; bef += (c2 < chunk) ? v : 0; }
          part_t[pt * 32 + e] = tot; part_b[pt * 32 + e] = bef; }
        __syncthreads();
        if (cx.tid < NE) { int total = 0, before = 0;
#pragma unroll
            for (int i = 0; i < 16; ++i) { total += part_t[i * 32 + cx.tid]; before += part_b[i * 32 + cx.tid]; }
            s_tot[cx.tid] = total; s_before[cx.tid] = before; }
        __syncthreads();
        if (cx.tid < NE) { int ps = 0;
#pragma unroll
            for (int e2 = 0; e2 < NE; ++e2) { const int v = (s_tot[e2] + 255) & ~255; ps += (e2 < cx.tid) ? v : 0; }
            s_pstart[cx.tid] = ps; s_base[cx.tid] = ps + s_before[cx.tid]; }
        __syncthreads();
        { const int dest = s_base[ea] + ra; rowtok[dest] = a >> 2; arow[a] = dest; }
        if (chunk < NE) { const int e = chunk, lo = s_pstart[e] + s_tot[e], hi = s_pstart[e] + ((s_tot[e] + 255) & ~255); for (int i = lo + cx.tid; i < hi; i += NTHREADS) rowtok[i] = 0; }
        if (chunk == (int)blockIdx.x) {
            const int i = (int)blockIdx.x + (int)gridDim.x * cx.tid;
            if (i < NTILE_MAX) { int ee = 0;
#pragma unroll
                for (int e = 0; e < NE; ++e) if (s_tot[e] > 0 && s_pstart[e] <= i * 256) ee = e;
                tab[64 + i] = ee; }
            if (chunk == 0 && cx.tid == 0) tab[0] = (s_pstart[NE - 1] + ((s_tot[NE - 1] + 255) & ~255)) >> 8;
        }
        __syncthreads();
    }
}

__device__ __forceinline__ void phase_inproj(const P& p, LAS unsigned char* lds_, int wv_, int l) {
    pg8::Gemm g{(const bf16*)(p.ws + WS_H), (const bf16*)(p.ws + WS_WIN + (size_t)l * DIN * D), D, 0, 0};
    pg8::InprojOrder S; S.init(T, DIN, gridDim.x, blockIdx.x); S.gw0 = (int)blockIdx.x * NWAVES; S.njobs = gridDim.x == 256 ? 1 : 0; S.rot = gridDim.x == 256 ? (int)((blockIdx.x & 7u) % 7u) : 0;
    S.job = pg8::CvJob{p.in[14] + (size_t)l * NE * D * 2 * DFF, p.in[16] + (size_t)l * NE * DFF * D, p.ws + WS_WGU + (size_t)l * NE * 2 * DFF * D, p.ws + WS_WDN + (size_t)l * NE * D * DFF};
    pg8::EpiMix E{(bf16*)(p.ws + WS_Z), (size_t)T * D, D, 0, (pg8::f32x2*)(p.ws + WS_VST), (const float*)(p.ws + WS_HS), (const float*)(p.ws + WS_WSC) + (size_t)l * DIN};
    pg8::gemm_phase<pg8::EpiMix, pg8::InprojOrder, false, 2>(lds_, g, S, E, nullptr, wv_);
}
__device__ __forceinline__ void phase_outproj(const P& p, LAS unsigned char* lds_, int wv_, int l) {
    pg8::Gemm g{(const bf16*)(p.ws + WS_M), (const bf16*)(p.ws + WS_WOUT + (size_t)l * D * D), D, 0, 0};
    pg8::StaticOrder S; S.init(T, D, gridDim.x, blockIdx.x);
    bf16* xres = (bf16*)(p.ws + WS_XRES); const float* gate = (const float*)(p.ws + WS_MOD) + (size_t)l * 2 * 6144 + 2 * D; float* ssq = (float*)(p.ws + WS_SSQ);
    if (l == 0) { pg8::EpiResidual<true> E{p.in[0], xres, gate, ssq, D, SEQ, 6144, 0, 1.0f / (MSCALE * WSCALE)}; pg8::gemm_phase<pg8::EpiResidual<true>, pg8::StaticOrder, false, 1>(lds_, g, S, E, nullptr, wv_); }
    else { pg8::EpiResidual<false> E{xres, xres, gate, ssq, D, SEQ, 6144, 0, 1.0f / (MSCALE * WSCALE)}; pg8::gemm_phase<pg8::EpiResidual<false>, pg8::StaticOrder, false, 1>(lds_, g, S, E, nullptr, wv_); }
}
__device__ __forceinline__ int load_tile_table(const P& p, LAS unsigned char* lds_, int wv_) {
    const int* tab = (const int*)(p.ws + WS_TAB);
    const int ntiles = __builtin_amdgcn_readfirstlane(tab[0]);
    LAS int* te = (LAS int*)(lds_ + pg8::TILE_OFF);
    asm volatile("" : "+s"(wv_)); int t0 = wv_ * 64 + lane_now(); asm volatile("" : "+v"(t0));
    for (int i = t0; i < NTILE_MAX; i += NTHREADS) te[i] = tab[64 + i];
    __syncthreads();
    return ntiles;
}
constexpr int CW_POST = 8192;
__device__ __forceinline__ int moe_nfree(int ntiles) { const int G = gridDim.x; if (G != 256 || ntiles < 512) return 0; const int left = (ntiles * 8) % G; return left ? G - left : 0; }
__device__ __forceinline__ void phase_moe1(const P& p, LAS unsigned char* lds_, int wv_, int l) {
    const int ntiles = load_tile_table(p, lds_, wv_);
    const int nfree = moe_nfree(ntiles);
    unsigned* ctl = (unsigned*)(p.ws + WS_CTL); volatile LAS unsigned* xbw = (volatile LAS unsigned*)(lds_ + LDS_BYTES - 16);
    {
        pg8::Gemm g{(const bf16*)(p.ws + WS_H8), (const bf16*)(p.ws + WS_WGU + (size_t)l * NE * 2 * DFF * D), D, 0, (size_t)2 * DFF * D};
        pg8::Moe1Order S; S.init(ntiles, 2 * DFF / 256, gridDim.x, blockIdx.x, (const LAS int*)(lds_ + pg8::TILE_OFF));
        S.ploc = ctl + CW_POST + 2048 * l; S.ptop = ctl + CW_POST + 2048 * l + 1024; S.st = xbw; S.post_ui = nfree ? 7 : -1;
        pg8::EpiSwiglu E{p.ws + WS_ACT, DFF, 2 * DFF, p.in[15] + (size_t)l * NE * 2 * DFF, 1.0f / WSCALE, ASCALE};
        pg8::gemm_phase<pg8::EpiSwiglu, pg8::Moe1Order, true, true>(lds_, g, S, E, (const int*)(p.ws + WS_ROWTOK), wv_);
    }
    const int e = (int)blockIdx.x - (int)(gridDim.x - nfree);
    if (nfree > 0 && e >= 0) {
        asm volatile("" : "+s"(wv_));
        if (wv_ == 0 && lane_now() == 0) {
            unsigned* bar = ctl + CW_BAR; unsigned* ptop = ctl + CW_POST + 2048 * l + 1024; const unsigned nx = xbw[1];
            XB_SPIN(xb_ld(ptop) < nx, bar);
            __builtin_amdgcn_fence(__ATOMIC_ACQUIRE, "agent");
            asm volatile("s_waitcnt vmcnt(0)" ::: "memory");
        }
        __syncthreads();
        const int x = e & 7, k = e >> 3;
        pg8::EarlyOrder S; S.pm = 8 * pg8::moe_g0(x, ntiles) + (k & 7); S.pn = k >> 3; S.be = __builtin_amdgcn_readfirstlane(((const LAS int*)(lds_ + pg8::TILE_OFF))[S.pm]);
        pg8::Gemm g{(const bf16*)(p.ws + WS_ACT), (const bf16*)(p.ws + WS_WDN + (size_t)l * NE * D * DFF), DFF, 0, (size_t)D * DFF};
        pg8::EpiFp8Out E{p.ws + WS_Y, D, D, p.in[17] + (size_t)l * NE * D, 1.0f / (WSCALE * ASCALE), YSCALE};
        pg8::gemm_phase<pg8::EpiFp8Out, pg8::EarlyOrder, false, true>(lds_, g, S, E, nullptr, wv_);
    }
}
__device__ __forceinline__ void phase_moe2(const P& p, LAS unsigned char* lds_, int wv_, int l) {
    const int ntiles = load_tile_table(p, lds_, wv_);
    pg8::Gemm g{(const bf16*)(p.ws + WS_ACT), (const bf16*)(p.ws + WS_WDN + (size_t)l * NE * D * DFF), DFF, 0, (size_t)D * DFF};
    pg8::Moe2Order S; S.init(ntiles, gridDim.x, blockIdx.x, (const LAS int*)(lds_ + pg8::TILE_OFF), moe_nfree(ntiles));
    pg8::EpiFp8Out E{p.ws + WS_Y, D, D, p.in[17] + (size_t)l * NE * D, 1.0f / (WSCALE * ASCALE), YSCALE};
    pg8::gemm_phase<pg8::EpiFp8Out, pg8::Moe2Order, false, true>(lds_, g, S, E, nullptr, wv_);
}

static_assert((CW_BAR + XCD_BAR_WORDS) * 4 <= (int)CTL_BYTES, "barrier words inside the zeroed region");
__global__ void __launch_bounds__(NTHREADS, 2) k_mega(P p) {
    extern __shared__ __attribute__((aligned(16))) unsigned char lds_raw[];
    LAS unsigned char* const lds = (LAS unsigned char*)lds_raw;
    int wv = __builtin_amdgcn_readfirstlane((int)(threadIdx.x >> 6)); const bool thr0 = threadIdx.x == 0;
    volatile LAS unsigned* xbw = (volatile LAS unsigned*)(lds + LDS_BYTES - 16);
    if (threadIdx.x < 4) xbw[threadIdx.x] = 0u;
    __syncthreads();
    XcdBarrier bar = xcd_barrier_post((unsigned*)(p.ws + WS_CTL) + CW_BAR, xbw);
    phase_prologue(p, lds, wv);
    xcd_barrier(bar, wv);
    for (int l = 0; l < NL; ++l) {
        if (l == 0) phase_norm1<0>(p, lds, wv, l); else phase_norm1<1>(p, lds, wv, l);
        xcd_barrier(bar, wv);
        phase_inproj(p, lds, wv, l);
        xcd_barrier(bar, wv);
        phase_mixer(p, lds, wv, l);
        xcd_barrier(bar, wv);
        phase_outproj(p, lds, wv, l);
        xcd_barrier(bar, wv);
        phase_router(p, lds, wv, l);
        if (gridDim.x != NCHUNK) { xcd_barrier(bar, wv); phase_scatter(p, lds, wv); }
        xcd_barrier(bar, wv);
        phase_moe1(p, lds, wv, l);
        xcd_barrier(bar, wv);
        phase_moe2(p, lds, wv, l);
        xcd_barrier(bar, wv);
    }
    phase_norm1<2>(p, lds, wv, NL);
}

extern "C" void kernel_launch(void* const* d_in, const int* in_sizes, int n_in, void* d_out, int out_size, void* d_ws, size_t ws_size, hipStream_t stream) {
    static int grid = 0;
    if (grid == 0) {
        if (n_in != 19 || in_sizes[0] != T * D || out_size != T * D || ws_size < WS_END) { fprintf(stderr, "kernel_launch: unexpected shapes (n_in %d, in0 %d, out %d, ws %zu < %zu); nothing launched\n", n_in, n_in > 0 ? in_sizes[0] : -1, out_size, ws_size, (size_t)WS_END); grid = -1; return; }
        int dev = 0, cus = 0, per_cu = 0;
        if (hipGetDevice(&dev) != hipSuccess || hipDeviceGetAttribute(&cus, hipDeviceAttributeMultiprocessorCount, dev) != hipSuccess) { grid = -1; return; }
        if (hipFuncSetAttribute((const void*)k_mega, hipFuncAttributeMaxDynamicSharedMemorySize, LDS_BYTES) != hipSuccess) { fprintf(stderr, "kernel_launch: hipFuncSetAttribute failed\n"); grid = -1; return; }
        if (hipOccupancyMaxActiveBlocksPerMultiprocessor(&per_cu, (const void*)k_mega, NTHREADS, LDS_BYTES) != hipSuccess || per_cu < 1) fprintf(stderr, "kernel_launch: occupancy query reports %d blocks per CU\n", per_cu);
        (void)hipGetLastError();
        grid = cus;
    }
    if (grid < 0) return;
    P p{};
    for (int i = 0; i < 19; ++i) p.in[i] = (const float*)d_in[i];
    p.out = (float*)d_out; p.ws = (unsigned char*)d_ws;
    (void)hipMemsetAsync((char*)d_ws + WS_CTL, 0, CTL_BYTES, stream);
    hipLaunchKernelGGL(k_mega, dim3(grid), dim3(NTHREADS), LDS_BYTES, stream, p);
}
```
